# Optimizing an MI355X kernel written in HIP

```python
import jax, jax.numpy as jnp
from jax import lax
import numpy as np

D_MODEL = 1024
BATCH = 8
SEQ = 2048
DEPTH = 1
DEC_BATCH = 128
DEC_SEQ = 4
PAST_LEN = 16384
PAGE_SIZE = 128

CHUNK = 128
A_WIDTH = D_MODEL
A_GROUPS = 8
A_GROUP_DIM = A_WIDTH // A_GROUPS
B_WIDTH = D_MODEL
CONV_WIDTH = 3
PROJ_WIDTH = 3 * A_WIDTH + 4 * B_WIDTH + 2 * D_MODEL
DEEPNORM_ALPHA = (2.0 * DEPTH) ** 0.25
DEEPNORM_BETA = (8.0 * DEPTH) ** -0.25
LN_EPS = 1e-5
COND_SCALE = 0.3

kernel_name = "gated_parallel_chunkmlp_shortconv_step"

_SPLITS = tuple(int(i) for i in np.cumsum(
    [A_WIDTH, A_WIDTH, A_WIDTH, B_WIDTH, B_WIDTH, B_WIDTH, B_WIDTH, D_MODEL]))


def _layer_norm(x, gain, bias):
    xf = x.astype(jnp.float32)
    mu = jnp.mean(xf, axis=-1, keepdims=True)
    var = jnp.mean(jnp.square(xf - mu), axis=-1, keepdims=True)
    y = (xf - mu) * lax.rsqrt(var + LN_EPS)
    return (y * gain.astype(jnp.float32) + bias.astype(jnp.float32)).astype(x.dtype)


def _chunk_spatial_gate(v, w_s, b_s):
    n, length, _ = v.shape
    n_chunks = -(-length // CHUNK)
    pad = n_chunks * CHUNK - length
    vp = jnp.pad(v, ((0, 0), (0, pad), (0, 0)))
    vp = vp.reshape(n, n_chunks, CHUNK, A_GROUPS, A_GROUP_DIM)
    causal = jnp.tril(jnp.ones((CHUNK, CHUNK), dtype=bool))
    w = jnp.where(causal, w_s, 0)
    s = jnp.einsum('gts,ncsgd->nctgd', w, vp) + b_s.T[None, None, :, :, None]
    return s.reshape(n, n_chunks * CHUNK, A_WIDTH)[:, :length]


def _short_conv(z, prev, w_conv, b_conv):
    length = z.shape[1]
    zp = jnp.concatenate([prev, z], axis=1)
    y = b_conv
    for k in range(CONV_WIDTH):
        y = y + w_conv[k] * zp[:, k:k + length]
    return y, zp[:, length:]


def _layer(x, c, conv_prev, w_c, b_c, w_in, a_ln_g, a_ln_b, w_s, b_s,
           w_conv, b_conv, w_pa, w_pb, w_o, ln_g, ln_b):
    mod = c @ w_c + b_c
    shift, scale, gate = jnp.split(mod[:, None, :], 3, axis=-1)
    h = x * (1 + scale) + shift
    proj = h @ w_in
    u, v, z_a, b_g, c_g, h_b, z_b, g_a, g_b = jnp.split(proj, _SPLITS, axis=-1)
    v = _layer_norm(v, a_ln_g, a_ln_b)
    s = _chunk_spatial_gate(v, w_s, b_s)
    out_a = u * s * jax.nn.silu(z_a)
    conv_out, new_conv = _short_conv(c_g * h_b, conv_prev, w_conv, b_conv)
    out_b = b_g * conv_out * jax.nn.silu(z_b)
    merged = jax.nn.sigmoid(g_a) * (out_a @ w_pa) + jax.nn.sigmoid(g_b) * (out_b @ w_pb)
    y = merged @ w_o
    x_new = _layer_norm(DEEPNORM_ALPHA * x + (1 + gate) * y, ln_g, ln_b)
    return x_new, new_conv, v


def setup_inputs(seed: int = 0) -> dict:
    key = jax.random.key(seed)
    ks = jax.random.split(key, 24)
    nrm = lambda k, shape: jax.random.normal(k, shape, dtype=jnp.float32)
    d = D_MODEL
    return {
        "x_prompt": nrm(ks[0], (BATCH, SEQ, d)),
        "x_sample": nrm(ks[1], (DEC_BATCH, DEC_SEQ, d)),
        "state_conv": nrm(ks[2], (DEPTH, DEC_BATCH, CONV_WIDTH - 1, B_WIDTH)),
        "c_prompt": nrm(ks[3], (BATCH, d)),
        "c_sample": nrm(ks[4], (DEC_BATCH, d)),
        "w_c": nrm(ks[5], (DEPTH, d, 3 * d)) * (d ** -0.5) * COND_SCALE,
        "b_c": nrm(ks[6], (DEPTH, 3 * d)) * 0.02,
        "w_in": nrm(ks[7], (DEPTH, d, PROJ_WIDTH)) * (d ** -0.5),
        "a_ln_g": 1.0 + 0.02 * nrm(ks[8], (DEPTH, A_WIDTH)),
        "a_ln_b": 0.02 * nrm(ks[9], (DEPTH, A_WIDTH)),
        "w_s": nrm(ks[10], (DEPTH, A_GROUPS, CHUNK, CHUNK)) * (CHUNK ** -0.5),
        "b_s": 1.0 + 0.02 * nrm(ks[11], (DEPTH, A_GROUPS, CHUNK)),
        "w_conv": nrm(ks[12], (DEPTH, CONV_WIDTH, B_WIDTH)) * (CONV_WIDTH ** -0.5),
        "b_conv": 0.02 * nrm(ks[13], (DEPTH, B_WIDTH)),
        "w_pa": nrm(ks[14], (DEPTH, A_WIDTH, d)) * (A_WIDTH ** -0.5) * DEEPNORM_BETA,
        "w_pb": nrm(ks[15], (DEPTH, B_WIDTH, d)) * (B_WIDTH ** -0.5) * DEEPNORM_BETA,
        "w_o": nrm(ks[16], (DEPTH, d, d)) * (d ** -0.5) * DEEPNORM_BETA,
        "ln_g": 1.0 + 0.02 * nrm(ks[17], (DEPTH, d)),
        "ln_b": 0.02 * nrm(ks[18], (DEPTH, d)),
    }


def reference(x_prompt, x_sample, state_conv, c_prompt, c_sample, w_c, b_c, w_in,
              a_ln_g, a_ln_b, w_s, b_s, w_conv, b_conv, w_pa, w_pb, w_o, ln_g, ln_b):
    xp, xs = x_prompt, x_sample
    conv_prompt_rows, conv_sample_rows, chunk_v_rows = [], [], []
    zero_conv = jnp.zeros((xp.shape[0], CONV_WIDTH - 1, B_WIDTH), dtype=xp.dtype)
    for l in range(DEPTH):
        params = (w_c[l], b_c[l], w_in[l], a_ln_g[l], a_ln_b[l], w_s[l], b_s[l],
                  w_conv[l], b_conv[l], w_pa[l], w_pb[l], w_o[l], ln_g[l], ln_b[l])
        xp, conv_p, _ = _layer(xp, c_prompt, zero_conv, *params)
        xs, conv_s, v_s = _layer(xs, c_sample, state_conv[l], *params)
        conv_prompt_rows.append(conv_p)
        conv_sample_rows.append(conv_s)
        chunk_v_rows.append(v_s)
    new_conv_prompt = jnp.stack(conv_prompt_rows)
    new_conv_sample = jnp.stack(conv_sample_rows)
    new_chunk_v_sample = jnp.stack(chunk_v_rows)
    return (xp, xs, new_conv_prompt, new_conv_sample, new_chunk_v_sample)
```

```cpp
#define DIAG_SIMPLE_MOD 1
#define DIAG_SIMPLE_STATS 1
#include <hip/hip_runtime.h>
#include <cstdio>

#define LAS __attribute__((address_space(3)))
typedef unsigned short bf16_t;
typedef short bf16x8 __attribute__((ext_vector_type(8)));
typedef float f32x4 __attribute__((ext_vector_type(4)));
typedef float f32x16 __attribute__((ext_vector_type(16)));
typedef unsigned u32x4 __attribute__((ext_vector_type(4)));
typedef unsigned u32x2 __attribute__((ext_vector_type(2)));

constexpr int D = 1024, NBATCH = 8, SEQ = 2048, NS = 128, TS = 4;
constexpr int MP = NBATCH * SEQ, MS = NS * TS, M = MP + MS;
constexpr int NPROJ = 9216, NSEQ = NBATCH + NS;
constexpr float LN_EPS = 1e-5f;
constexpr float ALPHA = 1.18920711500272f;
constexpr size_t OUT_CONVP = (size_t)M * D, OUT_CONVS = OUT_CONVP + (size_t)NBATCH * 2 * D, OUT_CV = OUT_CONVS + (size_t)NS * 2 * D;
constexpr size_t MiB = 1u << 20;
constexpr size_t WS_STATS = 128 * 1024;
constexpr size_t WS_MOD = 1 * MiB;
constexpr size_t WS_ZERO_BYTES = 3 * MiB;
constexpr size_t WS_W1T = 3 * MiB;
constexpr size_t SLOT = (size_t)M * D * 2;
constexpr size_t WS_S0 = 21 * MiB;
constexpr size_t WS_H = WS_S0, WS_US = WS_S0 + SLOT, WS_V = WS_S0 + 2 * SLOT, WS_BS = WS_S0 + 3 * SLOT, WS_Z = WS_S0 + 4 * SLOT, WS_SGA = WS_S0 + 5 * SLOT, WS_SGB = WS_S0 + 6 * SLOT;
constexpr size_t WS_MG = WS_H;
constexpr size_t WS_END = WS_S0 + 7 * SLOT;
constexpr int LDS_BYTES = 147456;

struct Params {
    const float *x_prompt, *x_sample, *state_conv, *c_prompt, *c_sample, *w_c, *b_c, *w_in, *a_ln_g, *a_ln_b, *w_s, *b_s, *w_conv, *b_conv, *w_pa, *w_pb, *w_o, *ln_g, *ln_b;
    float* out; unsigned char* ws;
};

typedef __bf16 bf16x2_t __attribute__((ext_vector_type(2)));
typedef float f32x2_t __attribute__((ext_vector_type(2)));
__device__ __forceinline__ unsigned cvt_pk_bf16(float lo, float hi) { const f32x2_t v = {lo, hi}; const bf16x2_t b = __builtin_convertvector(v, bf16x2_t); return __builtin_bit_cast(unsigned, b); }
__device__ __forceinline__ float bf_lo(unsigned u) { return __uint_as_float(u << 16); }
__device__ __forceinline__ float bf_hi(unsigned u) { return __uint_as_float(u & 0xffff0000u); }
__device__ __forceinline__ float sigmoidf_(float x) { return __builtin_amdgcn_rcpf(1.0f + __expf(-x)); }
__device__ __forceinline__ float siluf_(float x) { return x * sigmoidf_(x); }
__device__ __forceinline__ float wave_sum(float v) {
#pragma unroll
    for (int o = 1; o < 64; o <<= 1) v += __shfl_xor(v, o);
    return v;
}

namespace pg8 {
constexpr int BM = 256, BK = 64, HALF = 128, HTB = HALF * BK * 2, STAGE_BYTES = 8 * HTB, NXCD = 8, WGM = 8;
__device__ __forceinline__ int lds_byte(int r, int c) { const int st = (r >> 4) * 2 + (c >> 5), rr = r & 15, cc = c & 31, ob = rr * 64 + cc * 2; return st * 1024 + (ob ^ (((ob >> 9) & 1) << 5)); }
__device__ __forceinline__ void stage_rc(int b, int& R, int& C) { const int st = b / 1024, sb = b % 1024, swz = sb ^ (((sb >> 9) & 1) << 5); R = (st >> 1) * 16 + swz / 64; C = (st & 1) * 32 + (swz % 64) / 2; }
__device__ __forceinline__ int perm32(int rho) { const int n = rho >> 4, i = rho & 15; return 8 * (i >> 2) + 4 * n + (i & 3); }

struct Unit { int pm, pn, half; };
struct GemmOp { const bf16_t* A0; const bf16_t* B0; const bf16_t* A1; const bf16_t* B1; int lda, ldb, nt; };

struct StaticOrder {
    int nM, nN, nwg, G, c;
    __device__ void init(int M_, int N_, int G_, int c_) { nM = M_ / BM; nN = N_ / BM; nwg = nM * nN; G = G_; c = c_; }
    __device__ __forceinline__ bool next(int i, Unit& u) const {
        const long L = (long)i * G + c; if (L >= nwg) return false;
        int wgid = (int)L; { const int q = nwg / NXCD, r = nwg % NXCD, xcd = wgid % NXCD, off = wgid / NXCD; wgid = (xcd < r ? xcd * (q + 1) : r * (q + 1) + (xcd - r) * q) + off; }
        const int nig = WGM * nN, gid = wgid / nig, fm = gid * WGM, gsz = (nM - fm) < WGM ? (nM - fm) : WGM;
        u.pm = fm + ((wgid % nig) % gsz); u.pn = (wgid % nig) / gsz; u.half = 0; return true;
    }
};
struct PairOrder {
    StaticOrder so;
    __device__ __forceinline__ bool next(int i, Unit& u) const { if (!so.next(i >> 1, u)) return false; u.half = i & 1; return true; }
};

template <class Epi, class Sched>
__device__ __forceinline__ void gemm_phase(LAS unsigned char* lds, const GemmOp g, const Sched& S, const Epi& E) {
    int tid = threadIdx.x; asm volatile("" : "+v"(tid));
    const int wid = __builtin_amdgcn_readfirstlane(tid >> 6), lane = tid & 63, wr = wid >> 2, wc = wid & 3, fr = lane & 15, fq = lane >> 4;
    const int nt = g.nt;
    unsigned voffA[2], voffB[2];
#pragma unroll
    for (int i = 0; i < 2; ++i) { int R, C; stage_rc(tid * 16 + i * 8192, R, C); const int Rb = Epi::PERM ? ((R & ~31) + perm32(R & 31)) : R;
        voffA[i] = (unsigned)(R * g.lda + C) * 2u; voffB[i] = (unsigned)(Rb * g.ldb + C) * 2u; }
    const size_t kstep = (size_t)(BK * 2);
    const size_t hstepA = (size_t)HALF * g.lda * 2, hstepB = (size_t)HALF * g.ldb * 2;
    const size_t tstepA = 2 * hstepA, tstepB = 2 * hstepB;
    const unsigned ldsw = (unsigned)wid * 1024u;
    const int aoff = lds_byte(wr * 64 + fr, fq * 8), boff = lds_byte(wc * 32 + fr, fq * 8);
#define PG8_SA(b, h) (((b) * 2 + (h)) * HTB)
#define PG8_SB(b, h) ((4 + (b) * 2 + (h)) * HTB)
#define PG8_STAGE(bufoff, gbase, voff) do { _Pragma("unroll") for (int _i = 0; _i < 2; ++_i) \
        __builtin_amdgcn_global_load_lds((const unsigned*)((const char*)(gbase) + (voff)[_i]), (LAS unsigned*)(lds + (bufoff) + ldsw + _i * 8192), 16, 0, 0); } while (0)
#define PG8_LDA(dst, b, h) do { _Pragma("unroll") for (int m = 0; m < 4; ++m) _Pragma("unroll") for (int k = 0; k < 2; ++k) dst[m][k] = *(const LAS bf16x8*)(lds + PG8_SA(b, h) + aoff + m * 2048 + k * 1024); } while (0)
#define PG8_LDB(dst, b, h) do { _Pragma("unroll") for (int n = 0; n < 2; ++n) _Pragma("unroll") for (int k = 0; k < 2; ++k) dst[n][k] = *(const LAS bf16x8*)(lds + PG8_SB(b, h) + boff + n * 2048 + k * 1024); } while (0)
#define PG8_MMA(ai, bj, At, Bt) do { __builtin_amdgcn_s_setprio(1); _Pragma("unroll") for (int m = 0; m < 4; ++m) _Pragma("unroll") for (int n = 0; n < 2; ++n) _Pragma("unroll") for (int k = 0; k < 2; ++k) \
        acc[ai][bj][m][n] = __builtin_amdgcn_mfma_f32_16x16x32_bf16(Bt[n][k], At[m][k], acc[ai][bj][m][n], 0, 0, 0); __builtin_amdgcn_s_setprio(0); } while (0)
#define PG8_WAIT_V(n) asm volatile("s_waitcnt vmcnt(" #n ")" ::: "memory")
#define PG8_WAIT_L(n) asm volatile("s_waitcnt lgkmcnt(" #n ")" ::: "memory")
#define PG8_BAR __builtin_amdgcn_s_barrier()
#define PG8_SCHED __builtin_amdgcn_sched_barrier(0)
    Unit cur, nxt; int ui = 0;
    if (!S.next(0, cur)) return;
    f32x4 acc[2][2][4][2];
#pragma unroll
    for (int a = 0; a < 2; ++a)
#pragma unroll
        for (int b = 0; b < 2; ++b)
#pragma unroll
            for (int m = 0; m < 4; ++m)
#pragma unroll
                for (int n = 0; n < 2; ++n) acc[a][b][m][n] = (f32x4){0.f, 0.f, 0.f, 0.f};
    bf16x8 At[4][2], B0[2][2], B1[2][2];
    const char* cA = (const char*)(cur.half ? g.A1 : g.A0) + (size_t)cur.pm * tstepA; const char* cB = (const char*)(cur.half ? g.B1 : g.B0) + (size_t)cur.pn * tstepB;
    PG8_STAGE(PG8_SB(0, 0), cB, voffB); PG8_STAGE(PG8_SA(0, 0), cA, voffA); PG8_STAGE(PG8_SB(0, 1), cB + hstepB, voffB); PG8_STAGE(PG8_SA(0, 1), cA + hstepA, voffA);
    if (wr == 1) PG8_BAR;
    PG8_WAIT_V(4); PG8_BAR;
    PG8_STAGE(PG8_SB(1, 0), cB + kstep, voffB); PG8_STAGE(PG8_SA(1, 0), cA + kstep, voffA); PG8_STAGE(PG8_SB(1, 1), cB + hstepB + kstep, voffB);
    PG8_WAIT_V(6); PG8_BAR;
    for (;;) {
        const bool has_next = S.next(ui + 1, nxt);
        const char* nA = has_next ? (const char*)(nxt.half ? g.A1 : g.A0) + (size_t)nxt.pm * tstepA : cA; const char* nB = has_next ? (const char*)(nxt.half ? g.B1 : g.B0) + (size_t)nxt.pn * tstepB : cB;
        for (int t = 0; t < nt; t += 2) {
            const bool last = (t == nt - 2);
            const char* a1 = cA + (size_t)(t + 1) * kstep;
            const char* a2 = last ? nA : cA + (size_t)(t + 2) * kstep; const char* b2 = last ? nB : cB + (size_t)(t + 2) * kstep;
            const char* a3 = a2 + kstep; const char* b3 = b2 + kstep;
            PG8_LDB(B0, 0, 0); PG8_SCHED; PG8_LDA(At, 0, 0); PG8_STAGE(PG8_SA(1, 1), a1 + hstepA, voffA);
            PG8_WAIT_L(8); PG8_BAR; PG8_WAIT_L(0); PG8_MMA(0, 0, At, B0); PG8_BAR; PG8_SCHED;
            PG8_LDB(B1, 0, 1); PG8_STAGE(PG8_SB(0, 0), b2, voffB);
            PG8_BAR; PG8_WAIT_L(0); PG8_MMA(0, 1, At, B1); PG8_BAR;
            PG8_LDA(At, 0, 1); PG8_STAGE(PG8_SA(0, 0), a2, voffA);
            PG8_BAR; PG8_WAIT_L(0); PG8_MMA(1, 0, At, B0); PG8_BAR; PG8_SCHED;
            PG8_STAGE(PG8_SB(0, 1), b2 + hstepB, voffB);
            PG8_WAIT_V(6); PG8_BAR; PG8_MMA(1, 1, At, B1); PG8_BAR;
            PG8_LDB(B0, 1, 0); PG8_SCHED; PG8_LDA(At, 1, 0); PG8_STAGE(PG8_SA(0, 1), a2 + hstepA, voffA);
            PG8_WAIT_L(8); PG8_BAR; PG8_WAIT_L(0); PG8_MMA(0, 0, At, B0); PG8_BAR; PG8_SCHED;
            PG8_LDB(B1, 1, 1); PG8_STAGE(PG8_SB(1, 0), b3, voffB);
            PG8_BAR; PG8_WAIT_L(0); PG8_MMA(0, 1, At, B1); PG8_BAR;
            PG8_LDA(At, 1, 1); PG8_STAGE(PG8_SA(1, 0), a3, voffA);
            PG8_BAR; PG8_WAIT_L(0); PG8_MMA(1, 0, At, B0); PG8_BAR; PG8_SCHED;
            PG8_STAGE(PG8_SB(1, 1), b3 + hstepB, voffB);
            PG8_WAIT_V(6); PG8_BAR; PG8_MMA(1, 1, At, B1); PG8_BAR;
        }
        E(acc, cur, wr, wc, fr, fq);
        if (!has_next) break;
        cur = nxt; cA = nA; cB = nB; ++ui;
    }
    PG8_WAIT_V(0);
    if (wr == 0) PG8_BAR;
    PG8_BAR;
#undef PG8_SA
#undef PG8_SB
#undef PG8_STAGE
#undef PG8_LDA
#undef PG8_LDB
#undef PG8_MMA
#undef PG8_WAIT_V
#undef PG8_WAIT_L
#undef PG8_BAR
#undef PG8_SCHED
}
}

__device__ __forceinline__ void zero_acc(f32x4 (&acc)[2][2][4][2]) {
#pragma unroll
    for (int a = 0; a < 2; ++a)
#pragma unroll
        for (int b = 0; b < 2; ++b)
#pragma unroll
            for (int m = 0; m < 4; ++m)
#pragma unroll
                for (int n = 0; n < 2; ++n) acc[a][b][m][n] = (f32x4){0.f, 0.f, 0.f, 0.f};
}

struct Epi1 {
    static constexpr bool PERM = true;
    unsigned char* s0; float* stats;
    __device__ __forceinline__ void operator()(f32x4 (&acc)[2][2][4][2], const pg8::Unit& u, int wr, int wc, int fr, int fq) const {
        const int pn = u.pn, row0 = u.pm * 256 + wr * 64 + fr;
        if (pn < 8 || pn >= 12) {
            int slot, idx, mode;
            if (pn < 8) { slot = 1; idx = pn; mode = 0; } else if (pn < 20) { slot = 3; idx = pn - 12; mode = 0; } else if (pn < 28) { slot = 4; idx = pn - 20; mode = 1; } else { slot = 5; idx = pn - 28; mode = 2; }
            bf16_t* O = (bf16_t*)(s0 + (size_t)slot * SLOT);
            const int col0 = idx * 128 + wc * 32 + fq * 8;
#pragma unroll
            for (int ai = 0; ai < 2; ++ai)
#pragma unroll
                for (int m = 0; m < 4; ++m) {
                    bf16_t* rowp = O + (size_t)(row0 + ai * 128 + m * 16) * D + col0;
                    f32x4 r0, r1; const f32x4 a0 = acc[ai][0][m][0], a1 = acc[ai][0][m][1], b0 = acc[ai][1][m][0], b1 = acc[ai][1][m][1];
                    if (mode == 0) {
#pragma unroll
                        for (int j = 0; j < 4; ++j) { r0[j] = a0[j] * siluf_(b0[j]); r1[j] = a1[j] * siluf_(b1[j]); }
                    } else if (mode == 1) { r0 = a0 * b0; r1 = a1 * b1; }
                    else {
                        f32x4 s0v, s1v;
#pragma unroll
                        for (int j = 0; j < 4; ++j) { const float ea0 = 1.0f + __expf(-a0[j]), eb0 = 1.0f + __expf(-b0[j]), ea1 = 1.0f + __expf(-a1[j]), eb1 = 1.0f + __expf(-b1[j]);
                            r0[j] = eb0 * __builtin_amdgcn_rcpf(ea0); r1[j] = eb1 * __builtin_amdgcn_rcpf(ea1); s0v[j] = __builtin_amdgcn_rcpf(eb0); s1v[j] = __builtin_amdgcn_rcpf(eb1); }
                        u32x4 w2; w2.x = cvt_pk_bf16(s0v[0], s0v[1]); w2.y = cvt_pk_bf16(s0v[2], s0v[3]); w2.z = cvt_pk_bf16(s1v[0], s1v[1]); w2.w = cvt_pk_bf16(s1v[2], s1v[3]);
                        *(u32x4*)((char*)rowp + SLOT) = w2;
                    }
                    u32x4 w; w.x = cvt_pk_bf16(r0[0], r0[1]); w.y = cvt_pk_bf16(r0[2], r0[3]); w.z = cvt_pk_bf16(r1[0], r1[1]); w.w = cvt_pk_bf16(r1[2], r1[3]);
                    *(u32x4*)rowp = w;
                }
        } else {
            bf16_t* O = (bf16_t*)(s0 + (size_t)2 * SLOT);
            const int col0 = (pn - 8) * 256 + wc * 32 + fq * 8;
#pragma unroll
            for (int ai = 0; ai < 2; ++ai)
#pragma unroll
                for (int m = 0; m < 4; ++m) {
                    const int row = row0 + ai * 128 + m * 16;
                    bf16_t* rowp = O + (size_t)row * D + col0;
                    float s = 0.f, q = 0.f;
#pragma unroll
                    for (int bj = 0; bj < 2; ++bj) {
                        const f32x4 r0 = acc[ai][bj][m][0], r1 = acc[ai][bj][m][1];
#pragma unroll
                        for (int j = 0; j < 4; ++j) { s += r0[j] + r1[j]; q += r0[j] * r0[j] + r1[j] * r1[j]; }
                        u32x4 w; w.x = cvt_pk_bf16(r0[0], r0[1]); w.y = cvt_pk_bf16(r0[2], r0[3]); w.z = cvt_pk_bf16(r1[0], r1[1]); w.w = cvt_pk_bf16(r1[2], r1[3]);
                        *(u32x4*)(rowp + bj * 128) = w;
                    }
                    s += __shfl_xor(s, 16); s += __shfl_xor(s, 32); q += __shfl_xor(q, 16); q += __shfl_xor(q, 32);
                    if (fq == 0) { atomicAdd(stats + 2 * row, s); atomicAdd(stats + 2 * row + 1, q); }
                }
        }
        zero_acc(acc);
    }
};

#define G2_LD(o, v, s, imm) "global_load_dwordx4 %" #o ", %" #v ", %" #s " offset:" #imm "\n\t"
#define G2_ST(v, d, s, imm) "global_store_dwordx4 %" #v ", %" #d ", %" #s " offset:" #imm "\n\t"
struct Epi2 {
    static constexpr bool PERM = true;
    const bf16_t *RT, *SGB; bf16_t* MG;
    __device__ __forceinline__ void operator()(f32x4 (&acc)[2][2][4][2], const pg8::Unit& u, int wr, int wc, int fr, int fq) const {
        const unsigned l0 = (unsigned)(fr * D + wc * 32 + fq * 8) * 2u, l1 = l0 + 16 * D * 2;
        const size_t tb = ((size_t)(u.pm * 256 + wr * 64) * D + (size_t)u.pn * 256) * 2;
        const char* src = (const char*)(u.half == 0 ? RT : SGB) + tb;
#pragma unroll
        for (int ai = 0; ai < 2; ++ai)
#pragma unroll
            for (int mh = 0; mh < 2; ++mh) {
                const size_t rb = (size_t)(ai * 128 + mh * 32) * D * 2;
                const char* pg = src + rb;
                u32x4 gv[2][2];
                asm volatile(G2_LD(0, 4, 6, 0) G2_LD(1, 4, 6, 256) G2_LD(2, 5, 6, 0) G2_LD(3, 5, 6, 256)
                             "s_waitcnt vmcnt(0)"
                             : "=&v"(gv[0][0]), "=&v"(gv[0][1]), "=&v"(gv[1][0]), "=&v"(gv[1][1])
                             : "v"(l0), "v"(l1), "s"(pg) : "memory");
#pragma unroll
                for (int mm = 0; mm < 2; ++mm)
#pragma unroll
                    for (int bj = 0; bj < 2; ++bj) {
                        const int m = 2 * mh + mm; const u32x4 b = gv[mm][bj];
                        acc[ai][bj][m][0] *= (f32x4){bf_lo(b.x), bf_hi(b.x), bf_lo(b.y), bf_hi(b.y)};
                        acc[ai][bj][m][1] *= (f32x4){bf_lo(b.z), bf_hi(b.z), bf_lo(b.w), bf_hi(b.w)};
                    }
                if (u.half != 0) {
                    char* po = (char*)MG + tb + rb;
                    u32x4 w[2][2];
#pragma unroll
                    for (int mm = 0; mm < 2; ++mm)
#pragma unroll
                        for (int bj = 0; bj < 2; ++bj) {
                            const int m = 2 * mh + mm; const f32x4 a0 = acc[ai][bj][m][0], a1 = acc[ai][bj][m][1];
                            w[mm][bj].x = cvt_pk_bf16(a0[0], a0[1]); w[mm][bj].y = cvt_pk_bf16(a0[2], a0[3]); w[mm][bj].z = cvt_pk_bf16(a1[0], a1[1]); w[mm][bj].w = cvt_pk_bf16(a1[2], a1[3]);
                        }
                    asm volatile(G2_ST(4, 0, 6, 0) G2_ST(4, 1, 6, 256) G2_ST(5, 2, 6, 0) G2_ST(5, 3, 6, 256)
                                 "s_nop 1"
                                 :: "v"(w[0][0]), "v"(w[0][1]), "v"(w[1][0]), "v"(w[1][1]), "v"(l0), "v"(l1), "s"(po) : "memory");
                }
            }
        if (u.half != 0) zero_acc(acc);
    }
};

struct Epi3 {
    static constexpr bool PERM = false;
    const float *x_prompt, *x_sample, *mod; float* out;
    __device__ __forceinline__ void operator()(f32x4 (&acc)[2][2][4][2], const pg8::Unit& u, int wr, int wc, int fr, int fq) const {
        const int lrow0 = wr * 64 + fr, col0 = u.pn * 256 + wc * 32 + 4 * fq;
        const bool prompt = u.pm < 64;
        const float* xb = prompt ? x_prompt + (size_t)u.pm * 256 * D : x_sample + (size_t)(u.pm - 64) * 256 * D;
#pragma unroll
        for (int ai = 0; ai < 2; ++ai)
#pragma unroll
            for (int m = 0; m < 4; ++m) {
                const int lr = lrow0 + ai * 128 + m * 16;
                const int sq = prompt ? (u.pm >> 3) : (NBATCH + (((u.pm - 64) * 256 + lr) >> 2));
                const float* gp = mod + (size_t)sq * 3072 + 2048 + col0;
                const float* xp = xb + (size_t)lr * D + col0;
                float* op = out + ((size_t)u.pm * 256 + lr) * D + col0;
#pragma unroll
                for (int bj = 0; bj < 2; ++bj)
#pragma unroll
                    for (int n = 0; n < 2; ++n) {
                        const f32x4 gv = *(const f32x4*)(gp + bj * 128 + n * 16), xv = *(const f32x4*)(xp + bj * 128 + n * 16);
                        *(f32x4*)(op + bj * 128 + n * 16) = xv * ALPHA + (gv + 1.0f) * acc[ai][bj][m][n];
                    }
            }
        zero_acc(acc);
    }
};

__device__ __forceinline__ int src_col(int n) {
    const int t = n >> 8, r = n & 255;
    if (t < 8) return r < 128 ? 128 * t + r : 2048 + 128 * t + (r - 128);
    if (t < 12) return 1024 + 256 * (t - 8) + r;
    if (t < 20) return r < 128 ? 3072 + 128 * (t - 12) + r : 6144 + 128 * (t - 12) + (r - 128);
    if (t < 28) return r < 128 ? 4096 + 128 * (t - 20) + r : 5120 + 128 * (t - 20) + (r - 128);
    return r < 128 ? 7168 + 128 * (t - 28) + r : 8192 + 128 * (t - 28) + (r - 128);
}
__device__ __forceinline__ void transpose_item(const float* W, int ldw, int srccol0, bf16_t* WT, int ldt, int dstrow0, int k0, LAS float* scr, int lane) {
#pragma unroll 8
    for (int i = 0; i < 32; ++i) { const int kk = 2 * i + (lane >> 5); scr[kk * 33 + (lane & 31)] = W[(size_t)(k0 + kk) * ldw + srccol0 + (lane & 31)]; }
    asm volatile("s_waitcnt lgkmcnt(0)" ::: "memory");
    const int c = lane & 7;
#pragma unroll
    for (int j = 0; j < 4; ++j) { const int n = (lane >> 3) + 8 * j; const LAS float* s = scr + (8 * c) * 33 + n;
        u32x4 o; o.x = cvt_pk_bf16(s[0 * 33], s[1 * 33]); o.y = cvt_pk_bf16(s[2 * 33], s[3 * 33]); o.z = cvt_pk_bf16(s[4 * 33], s[5 * 33]); o.w = cvt_pk_bf16(s[6 * 33], s[7 * 33]);
        *(u32x4*)(WT + (size_t)(dstrow0 + n) * ldt + k0 + 8 * c) = o; }
    asm volatile("s_waitcnt lgkmcnt(0)" ::: "memory");
}

__device__ __forceinline__ void phase0(const Params& p, LAS unsigned char* lds, int wave, int lane) {
    const int gw = blockIdx.x * 8 + wave, NGW = gridDim.x * 8;
    float* mod = (float*)(p.ws + WS_MOD);
#if DIAG_SIMPLE_MOD
    for (int o = blockIdx.x * 512 + threadIdx.x; o < NSEQ * 3072; o += gridDim.x * 512) {
        const int row = o / 3072, col = o % 3072;
        const float* cr = row < NBATCH ? p.c_prompt + (size_t)row * D : p.c_sample + (size_t)(row - NBATCH) * D;
        float s = 0.f;
        for (int k = 0; k < D; ++k) s += cr[k] * p.w_c[(size_t)k * 3072 + col];
        mod[o] = s + p.b_c[col];
    }
    for (int task = gw; task < 0; task += NGW) {
#else
    for (int task = gw; task < 5 * 96 * 4; task += NGW) {
#endif
        const int ks = task & 3, ob = task >> 2, rb = ob / 96, cb = ob % 96, h = lane >> 5;
        int arow = 32 * rb + (lane & 31); if (arow > NSEQ - 1) arow = NSEQ - 1;
        const float* ap = (arow < NBATCH ? p.c_prompt + (size_t)arow * D : p.c_sample + (size_t)(arow - NBATCH) * D) + 256 * ks + 128 * h;
        const float* bp = p.w_c + (size_t)(256 * ks + 128 * h) * 3072 + 32 * cb + (lane & 31);
        f32x16 acc;
#pragma unroll
        for (int r = 0; r < 16; ++r) acc[r] = 0.f;
#pragma unroll 1
        for (int i0 = 0; i0 < 128; i0 += 8, ap += 8, bp += 8 * 3072) {
            const f32x4 a0 = *(const f32x4*)ap, a1 = *(const f32x4*)(ap + 4);
            float b[8];
#pragma unroll
            for (int e = 0; e < 8; ++e) b[e] = bp[(size_t)e * 3072];
#pragma unroll
            for (int e = 0; e < 4; ++e) acc = __builtin_amdgcn_mfma_f32_32x32x2f32(a0[e], b[e], acc, 0, 0, 0);
#pragma unroll
            for (int e = 0; e < 4; ++e) acc = __builtin_amdgcn_mfma_f32_32x32x2f32(a1[e], b[4 + e], acc, 0, 0, 0);
        }
        const int col = 32 * cb + (lane & 31); const float bias = (ks == 0) ? p.b_c[col] : 0.f;
#pragma unroll
        for (int r = 0; r < 16; ++r) { const int row = 32 * rb + (r & 3) + 8 * (r >> 2) + 4 * h; if (row < NSEQ) atomicAdd(mod + (size_t)row * 3072 + col, acc[r] + bias); }
    }
    LAS float* scr = (LAS float*)(lds + wave * 16384);
    bf16_t* W1T = (bf16_t*)(p.ws + WS_W1T);
    for (int it = gw; it < 16 * 288; it += NGW) { const int kb = it / 288, nb = it % 288; transpose_item(p.w_in, NPROJ, src_col(32 * nb), W1T, D, 32 * nb, 64 * kb, scr, lane); }
}

__device__ __forceinline__ void phase1(const Params& p) {
    const float* mod = (const float*)(p.ws + WS_MOD); bf16_t* H = (bf16_t*)(p.ws + WS_H);
    const int nth = gridDim.x * 512;
    for (int it = blockIdx.x * 512 + threadIdx.x; it < M * 128; it += nth) {
        const int row = it >> 7, c8 = (it & 127) * 8;
        const float* xr = (row < MP ? p.x_prompt + (size_t)row * D : p.x_sample + (size_t)(row - MP) * D) + c8;
        const int sq = row < MP ? (row >> 11) : NBATCH + ((row - MP) >> 2);
        const float* mr = mod + (size_t)sq * 3072 + c8;
        const f32x4 x0 = *(const f32x4*)xr, x1 = *(const f32x4*)(xr + 4), sh0 = *(const f32x4*)mr, sh1 = *(const f32x4*)(mr + 4), sc0 = *(const f32x4*)(mr + 1024), sc1 = *(const f32x4*)(mr + 1028);
        const f32x4 h0 = x0 * (sc0 + 1.0f) + sh0, h1 = x1 * (sc1 + 1.0f) + sh1;
        u32x4 w; w.x = cvt_pk_bf16(h0[0], h0[1]); w.y = cvt_pk_bf16(h0[2], h0[3]); w.z = cvt_pk_bf16(h1[0], h1[1]); w.w = cvt_pk_bf16(h1[2], h1[3]);
        *(u32x4*)(H + (size_t)row * D + c8) = w;
    }
}

__device__ __forceinline__ void unpack8(const u32x4 r, float (&f)[8]) { f[0] = bf_lo(r.x); f[1] = bf_hi(r.x); f[2] = bf_lo(r.y); f[3] = bf_hi(r.y); f[4] = bf_lo(r.z); f[5] = bf_hi(r.z); f[6] = bf_lo(r.w); f[7] = bf_hi(r.w); }

__device__ __forceinline__ void phase3(const Params& p, LAS unsigned char* lds, int wave, int lane) {
    const int tid = threadIdx.x;
    bf16_t* US = (bf16_t*)(p.ws + WS_US); const bf16_t* V = (const bf16_t*)(p.ws + WS_V); bf16_t* BS = (bf16_t*)(p.ws + WS_BS); const bf16_t* Z = (const bf16_t*)(p.ws + WS_Z);
#if DIAG_SIMPLE_STATS
    const float* stats = (const float*)(p.ws + WS_STATS + 512 * 1024);
#else
    const float* stats = (const float*)(p.ws + WS_STATS);
#endif
    constexpr int LS = 136;
    LAS bf16_t* Wl = (LAS bf16_t*)lds;
    LAS bf16_t* Vl = Wl + 128 * LS;
    for (int unit = blockIdx.x; unit < 1024; unit += gridDim.x) {
        const int c = unit >> 3, g = unit & 7, r0 = 128 * c;
        __syncthreads();
        for (int q = tid; q < 2048; q += 512) {
            const int t = q >> 4, j8 = (q & 15) * 8; const float* wp = p.w_s + ((size_t)(g * 128 + t) * 128 + j8);
            f32x4 w0 = *(const f32x4*)wp, w1 = *(const f32x4*)(wp + 4);
#pragma unroll
            for (int e = 0; e < 4; ++e) { if (j8 + e > t) w0[e] = 0.f; if (j8 + 4 + e > t) w1[e] = 0.f; }
            u32x4 o; o.x = cvt_pk_bf16(w0[0], w0[1]); o.y = cvt_pk_bf16(w0[2], w0[3]); o.z = cvt_pk_bf16(w1[0], w1[1]); o.w = cvt_pk_bf16(w1[2], w1[3]);
            *(LAS u32x4*)(Wl + t * LS + j8) = o;
        }
        {
            const int jb = tid >> 4, c8 = (tid & 15) * 8, ch = 128 * g + c8;
            float gam[8], bet[8];
            { const f32x4 g0 = *(const f32x4*)(p.a_ln_g + ch), g1 = *(const f32x4*)(p.a_ln_g + ch + 4), b0 = *(const f32x4*)(p.a_ln_b + ch), b1 = *(const f32x4*)(p.a_ln_b + ch + 4);
#pragma unroll
              for (int e = 0; e < 4; ++e) { gam[e] = g0[e]; gam[4 + e] = g1[e]; bet[e] = b0[e]; bet[4 + e] = b1[e]; } }
            float f[4][8];
#pragma unroll
            for (int e = 0; e < 4; ++e) {
                const int row = r0 + 4 * jb + e;
                const u32x4 raw = *(const u32x4*)(V + (size_t)row * D + ch);
                const float sm = stats[2 * row], sq = stats[2 * row + 1];
                const float mu = sm * (1.0f / D), var = fmaxf(sq * (1.0f / D) - mu * mu, 0.f), rstd = 1.0f / sqrtf(var + LN_EPS);
                float x[8]; unpack8(raw, x);
#pragma unroll
                for (int k = 0; k < 8; ++k) f[e][k] = (x[k] - mu) * rstd * gam[k] + bet[k];
            }
#pragma unroll
            for (int k = 0; k < 8; ++k) { u32x2 o; o.x = cvt_pk_bf16(f[0][k], f[1][k]); o.y = cvt_pk_bf16(f[2][k], f[3][k]); *(LAS u32x2*)(Vl + (c8 + k) * LS + 4 * jb) = o; }
        }
        __syncthreads();
        {
            const int fr = lane & 15, fq = lane >> 4, nks = ((16 * wave + 15) >> 5) + 1;
            f32x4 acc[8];
#pragma unroll
            for (int nb = 0; nb < 8; ++nb) acc[nb] = (f32x4){0.f, 0.f, 0.f, 0.f};
            for (int ks = 0; ks < nks; ++ks) {
                const bf16x8 bw = *(const LAS bf16x8*)(Wl + (16 * wave + fr) * LS + 32 * ks + 8 * fq);
#pragma unroll
                for (int nb = 0; nb < 8; ++nb) { const bf16x8 av = *(const LAS bf16x8*)(Vl + (16 * nb + fr) * LS + 32 * ks + 8 * fq); acc[nb] = __builtin_amdgcn_mfma_f32_16x16x32_bf16(av, bw, acc[nb], 0, 0, 0); }
            }
            const int t = 16 * wave + fr, row = r0 + t; const float bsv = p.b_s[g * 128 + t];
#pragma unroll
            for (int nb = 0; nb < 8; ++nb) {
                bf16_t* up = US + (size_t)row * D + 128 * g + 16 * nb + 4 * fq;
                const u32x2 uv = *(const u32x2*)up;
                u32x2 o; o.x = cvt_pk_bf16(bf_lo(uv.x) * (acc[nb][0] + bsv), bf_hi(uv.x) * (acc[nb][1] + bsv)); o.y = cvt_pk_bf16(bf_lo(uv.y) * (acc[nb][2] + bsv), bf_hi(uv.y) * (acc[nb][3] + bsv));
                *(u32x2*)up = o;
            }
        }
    }
    __syncthreads();
    {
        const int gw = blockIdx.x * 8 + wave, NGW = gridDim.x * 8;
        LAS float* scr = (LAS float*)(lds + wave * 16384);
        bf16_t* WT = (bf16_t*)(p.ws + WS_W1T);
        for (int it = gw; it < 3 * 512; it += NGW) { const int w = it >> 9, r = it & 511, kb = r >> 5, nb = r & 31;
            const float* src = w == 0 ? p.w_pa : (w == 1 ? p.w_pb : p.w_o);
            transpose_item(src, D, 32 * nb, WT + (size_t)w * D * D, D, 32 * nb, 64 * kb, scr, lane); }
    }
    const int gt = blockIdx.x * 512 + tid, nth = gridDim.x * 512;
    for (int it = gt; it < NS * 128; it += nth) {
        const int n = it >> 7, c8 = (it & 127) * 8, g = c8 >> 7, rowb = MP + 4 * n;
        float gam[8], bet[8];
        { const f32x4 g0 = *(const f32x4*)(p.a_ln_g + c8), g1 = *(const f32x4*)(p.a_ln_g + c8 + 4), b0 = *(const f32x4*)(p.a_ln_b + c8), b1 = *(const f32x4*)(p.a_ln_b + c8 + 4);
#pragma unroll
          for (int e = 0; e < 4; ++e) { gam[e] = g0[e]; gam[4 + e] = g1[e]; bet[e] = b0[e]; bet[4 + e] = b1[e]; } }
        float f[4][8];
#pragma unroll
        for (int e = 0; e < 4; ++e) {
            const int row = rowb + e;
            const u32x4 raw = *(const u32x4*)(V + (size_t)row * D + c8);
            const float sm = stats[2 * row], sq = stats[2 * row + 1];
            const float mu = sm * (1.0f / D), var = fmaxf(sq * (1.0f / D) - mu * mu, 0.f), rstd = 1.0f / sqrtf(var + LN_EPS);
            float x[8]; unpack8(raw, x);
#pragma unroll
            for (int k = 0; k < 8; ++k) f[e][k] = (x[k] - mu) * rstd * gam[k] + bet[k];
            float* cv = p.out + OUT_CV + ((size_t)(4 * n + e)) * D + c8;
            *(f32x4*)cv = (f32x4){f[e][0], f[e][1], f[e][2], f[e][3]}; *(f32x4*)(cv + 4) = (f32x4){f[e][4], f[e][5], f[e][6], f[e][7]};
        }
#pragma unroll
        for (int t = 0; t < 4; ++t) {
            const f32x4 wr4 = *(const f32x4*)(p.w_s + ((size_t)(g * 128 + t) * 128)); const float bsv = p.b_s[g * 128 + t];
            bf16_t* up = US + (size_t)(rowb + t) * D + c8; const u32x4 uv = *(const u32x4*)up; float us[8]; unpack8(uv, us);
            float o[8];
#pragma unroll
            for (int k = 0; k < 8; ++k) { float s = bsv;
#pragma unroll
                for (int j = 0; j < 4; ++j) if (j <= t) s += wr4[j] * f[j][k];
                o[k] = us[k] * s; }
            u32x4 w; w.x = cvt_pk_bf16(o[0], o[1]); w.y = cvt_pk_bf16(o[2], o[3]); w.z = cvt_pk_bf16(o[4], o[5]); w.w = cvt_pk_bf16(o[6], o[7]);
            *(u32x4*)up = w;
        }
    }
    for (int it = gt; it < (M / 4) * 128; it += nth) {
        const int rb = it >> 7, c8 = (it & 127) * 8, row0 = 4 * rb;
        float w0[8], w1[8], w2[8], bc[8];
        { const f32x4 a0 = *(const f32x4*)(p.w_conv + c8), a1 = *(const f32x4*)(p.w_conv + c8 + 4), b0 = *(const f32x4*)(p.w_conv + D + c8), b1 = *(const f32x4*)(p.w_conv + D + c8 + 4),
                      c0 = *(const f32x4*)(p.w_conv + 2 * D + c8), c1 = *(const f32x4*)(p.w_conv + 2 * D + c8 + 4), d0 = *(const f32x4*)(p.b_conv + c8), d1 = *(const f32x4*)(p.b_conv + c8 + 4);
#pragma unroll
          for (int e = 0; e < 4; ++e) { w0[e] = a0[e]; w0[4 + e] = a1[e]; w1[e] = b0[e]; w1[4 + e] = b1[e]; w2[e] = c0[e]; w2[4 + e] = c1[e]; bc[e] = d0[e]; bc[4 + e] = d1[e]; } }
        float zm2[8], zm1[8];
        if (row0 >= MP) {
            const int n = (row0 - MP) >> 2; const float* st = p.state_conv + (size_t)n * 2 * D + c8;
            const f32x4 s0 = *(const f32x4*)st, s1 = *(const f32x4*)(st + 4), s2 = *(const f32x4*)(st + D), s3 = *(const f32x4*)(st + D + 4);
#pragma unroll
            for (int e = 0; e < 4; ++e) { zm2[e] = s0[e]; zm2[4 + e] = s1[e]; zm1[e] = s2[e]; zm1[4 + e] = s3[e]; }
        } else if ((row0 & (SEQ - 1)) == 0) {
#pragma unroll
            for (int k = 0; k < 8; ++k) { zm2[k] = 0.f; zm1[k] = 0.f; }
        } else {
            unpack8(*(const u32x4*)(Z + (size_t)(row0 - 2) * D + c8), zm2); unpack8(*(const u32x4*)(Z + (size_t)(row0 - 1) * D + c8), zm1);
        }
#pragma unroll
        for (int e = 0; e < 4; ++e) {
            const int row = row0 + e;
            float z0[8], b[8], o[8]; unpack8(*(const u32x4*)(Z + (size_t)row * D + c8), z0); unpack8(*(const u32x4*)(BS + (size_t)row * D + c8), b);
#pragma unroll
            for (int k = 0; k < 8; ++k) o[k] = b[k] * (bc[k] + w0[k] * zm2[k] + w1[k] * zm1[k] + w2[k] * z0[k]);
            u32x4 w; w.x = cvt_pk_bf16(o[0], o[1]); w.y = cvt_pk_bf16(o[2], o[3]); w.z = cvt_pk_bf16(o[4], o[5]); w.w = cvt_pk_bf16(o[6], o[7]);
            *(u32x4*)(BS + (size_t)row * D + c8) = w;
            float* dst = nullptr;
            if (row < MP) { const int tt = row & (SEQ - 1); if (tt >= SEQ - 2) dst = p.out + OUT_CONVP + ((size_t)(row >> 11) * 2 + (tt - (SEQ - 2))) * D + c8; }
            else { const int tt = (row - MP) & 3; if (tt >= 2) dst = p.out + OUT_CONVS + ((size_t)((row - MP) >> 2) * 2 + (tt - 2)) * D + c8; }
            if (dst) { *(f32x4*)dst = (f32x4){z0[0], z0[1], z0[2], z0[3]}; *(f32x4*)(dst + 4) = (f32x4){z0[4], z0[5], z0[6], z0[7]}; }
#pragma unroll
            for (int k = 0; k < 8; ++k) { zm2[k] = zm1[k]; zm1[k] = z0[k]; }
        }
    }
}

__device__ __forceinline__ void phase6(const Params& p, int wave, int lane) {
    const int gw = blockIdx.x * 8 + wave, NGW = gridDim.x * 8;
    f32x4 gv[4], bv[4];
#pragma unroll
    for (int j = 0; j < 4; ++j) { gv[j] = *((const f32x4*)p.ln_g + lane + 64 * j); bv[j] = *((const f32x4*)p.ln_b + lane + 64 * j); }
    for (int row = gw; row < M; row += NGW) {
        f32x4* xr = (f32x4*)(p.out + (size_t)row * D) + lane;
        f32x4 v[4]; float s = 0.f;
#pragma unroll
        for (int j = 0; j < 4; ++j) { v[j] = xr[64 * j]; s += (v[j].x + v[j].y) + (v[j].z + v[j].w); }
        const float mean = wave_sum(s) * (1.f / D); float s2 = 0.f;
#pragma unroll
        for (int j = 0; j < 4; ++j) { v[j] = v[j] - mean; s2 += (v[j].x * v[j].x + v[j].y * v[j].y) + (v[j].z * v[j].z + v[j].w * v[j].w); }
        const float rstd = 1.f / sqrtf(wave_sum(s2) * (1.f / D) + LN_EPS);
#pragma unroll
        for (int j = 0; j < 4; ++j) xr[64 * j] = v[j] * rstd * gv[j] + bv[j];
    }
}


#define XB_TMO      128
#define XB_XCNT(j)  (256  + 64 * (j))
#define XB_XSUB(j)  (1280 + 64 * (j))
#define XB_XGEN(j)  (2304 + 64 * (j))
#define XB_TOP      3328
#define XB_TOPGEN   3392
#define XCD_BAR_WORDS 3456
#define XB_SPIN_CAP (1u << 18)
__device__ __forceinline__ unsigned xb_ld(unsigned* p)              { return __hip_atomic_load(p, __ATOMIC_RELAXED, __HIP_MEMORY_SCOPE_AGENT); }
__device__ __forceinline__ unsigned xb_add(unsigned* p, unsigned v) { return __hip_atomic_fetch_add(p, v, __ATOMIC_RELAXED, __HIP_MEMORY_SCOPE_AGENT); }
__device__ __forceinline__ unsigned xb_xcc_id() { return (unsigned)__builtin_amdgcn_s_getreg((3 << 11) | 20) & 0xFu; }
#define XB_SPIN(cond, bar) do { unsigned _sp = 0; while (cond) { __builtin_amdgcn_s_sleep(1); \
    if ((++_sp & 255u) == 0u) { if (xb_ld(&(bar)[XB_TMO])) break; if (_sp > XB_SPIN_CAP) { atomicAdd(&(bar)[XB_TMO], 1u); break; } } } } while (0)
struct XcdBarrier { unsigned* bar; unsigned x; volatile LAS unsigned* st; };
__device__ __forceinline__ XcdBarrier xcd_barrier_post(unsigned* bar, volatile LAS unsigned* st) {
    XcdBarrier b; b.bar = bar; b.x = xb_xcc_id(); b.st = st;
    if (threadIdx.x == 0) (void)xb_add(&bar[XB_XCNT(b.x)], 1u);
    return b;
}
__device__ __forceinline__ void xcd_barrier_complete(unsigned* bar, unsigned x, unsigned& nloc, unsigned& nx) {
    const unsigned G = gridDim.x * gridDim.y * gridDim.z;
    unsigned sum, cnt, mine, sp = 0u;
    for (;;) {
        sum = 0u; cnt = 0u; mine = 0u;
#pragma unroll
        for (unsigned j = 0; j < 16; ++j) { const unsigned c = xb_ld(&bar[XB_XCNT(j)]); sum += c; cnt += (c > 0u) ? 1u : 0u; mine = (j == x) ? c : mine; }
        if (sum == G) break;
        __builtin_amdgcn_s_sleep(1);
        if ((++sp & 255u) == 0u) { if (xb_ld(&bar[XB_TMO])) break; if (sp > XB_SPIN_CAP) { atomicAdd(&bar[XB_TMO], 1u); break; } }
    }
    nloc = mine > 0u ? mine : 1u; nx = cnt > 0u ? cnt : 1u;
}
__device__ __forceinline__ void xcd_barrier(const XcdBarrier& b) {
    asm volatile("s_waitcnt vmcnt(0)" ::: "memory");
    __syncthreads();
    if (threadIdx.x == 0) {
        unsigned* bar = b.bar;
        __builtin_amdgcn_s_waitcnt(0);
        unsigned nloc = b.st[0], nx = b.st[1];
        if (nloc == 0u) { xcd_barrier_complete(bar, b.x, nloc, nx); b.st[0] = nloc; b.st[1] = nx; }
        const unsigned old = xb_add(&bar[XB_XSUB(b.x)], 1u);
        const unsigned gen = old / nloc;
        if (old + 1u == (gen + 1u) * nloc) {
            __builtin_amdgcn_fence(__ATOMIC_RELEASE, "agent");
            asm volatile("s_waitcnt vmcnt(0)" ::: "memory");
            const unsigned og = xb_add(&bar[XB_TOP], 1u);
            const unsigned tg = og / nx;
            if (og + 1u == (tg + 1u) * nx) xb_add(&bar[XB_TOPGEN], 1u);
            else XB_SPIN(xb_ld(&bar[XB_TOPGEN]) == tg, bar);
            __builtin_amdgcn_fence(__ATOMIC_ACQUIRE, "agent");
            xb_add(&bar[XB_XGEN(b.x)], 1u);
            asm volatile("s_waitcnt vmcnt(0)" ::: "memory");
        } else {
            XB_SPIN(xb_ld(&bar[XB_XGEN(b.x)]) == gen, bar);
            __builtin_amdgcn_fence(__ATOMIC_ACQUIRE, "agent");
            asm volatile("s_waitcnt vmcnt(0)" ::: "memory");
        }
    }
    __syncthreads();
}

__global__ void __launch_bounds__(512, 2) mega_fwd(Params p) {
    extern __shared__ __attribute__((aligned(16))) unsigned char lds_raw[];
    LAS unsigned char* lds = (LAS unsigned char*)lds_raw;
    const int tid = threadIdx.x, lane = tid & 63, wave = __builtin_amdgcn_readfirstlane(tid >> 6);
    const int G = gridDim.x, bid = blockIdx.x;
    volatile LAS unsigned* bst = (volatile LAS unsigned*)(lds + 131072 + 64);
    if (tid < 2) bst[tid] = 0u;
    __syncthreads();
    const XcdBarrier bar = xcd_barrier_post((unsigned*)p.ws, bst);
#define GRID_BAR() xcd_barrier(bar)

    phase0(p, lds, wave, lane);
    GRID_BAR();
    phase1(p);
    GRID_BAR();
    {
        pg8::GemmOp g{(const bf16_t*)(p.ws + WS_H), (const bf16_t*)(p.ws + WS_W1T), nullptr, nullptr, D, D, D / 64};
        pg8::StaticOrder S; S.init(M, NPROJ, G, bid);
        Epi1 E{p.ws + WS_S0, (float*)(p.ws + WS_STATS)};
        pg8::gemm_phase<Epi1, pg8::StaticOrder>(lds, g, S, E);
    }
    GRID_BAR();
#if DIAG_SIMPLE_STATS
    {
        float* st2 = (float*)(p.ws + WS_STATS + 512 * 1024); const bf16_t* V = (const bf16_t*)(p.ws + WS_V);
        for (int row = bid * 8 + wave; row < M; row += G * 8) {
            float s = 0.f, q = 0.f;
            for (int c = lane; c < D; c += 64) { const float x = __uint_as_float((unsigned)V[(size_t)row * D + c] << 16); s += x; q += x * x; }
            s = wave_sum(s); q = wave_sum(q);
            if (lane == 0) { st2[2 * row] = s; st2[2 * row + 1] = q; }
        }
    }
    GRID_BAR();
#endif
    phase3(p, lds, wave, lane);
    GRID_BAR();
    {
        const bf16_t* WT = (const bf16_t*)(p.ws + WS_W1T);
        pg8::GemmOp g{(const bf16_t*)(p.ws + WS_US), WT, (const bf16_t*)(p.ws + WS_BS), WT + (size_t)D * D, D, D, D / 64};
        pg8::PairOrder S; S.so.init(M, D, G, bid);
        Epi2 E{(const bf16_t*)(p.ws + WS_SGA), (const bf16_t*)(p.ws + WS_SGB), (bf16_t*)(p.ws + WS_MG)};
        pg8::gemm_phase<Epi2, pg8::PairOrder>(lds, g, S, E);
    }
    GRID_BAR();
    {
        const bf16_t* WT = (const bf16_t*)(p.ws + WS_W1T);
        pg8::GemmOp g{(const bf16_t*)(p.ws + WS_MG), WT + (size_t)2 * D * D, nullptr, nullptr, D, D, D / 64};
        pg8::StaticOrder S; S.init(M, D, G, bid);
        Epi3 E{p.x_prompt, p.x_sample, (const float*)(p.ws + WS_MOD), p.out};
        pg8::gemm_phase<Epi3, pg8::StaticOrder>(lds, g, S, E);
    }
    GRID_BAR();
    phase6(p, wave, lane);
}

extern "C" void kernel_launch(void* const* d_in, const int* in_sizes, int n_in, void* d_out, int out_size, void* d_ws, size_t ws_size, hipStream_t stream) {
    static int grid = 0;
    if (grid == 0) {
        if (n_in != 19 || ws_size < WS_END) { fprintf(stderr, "kernel_launch: expected 19 inputs and >= %zu bytes of workspace (got %d, %zu)\n", (size_t)WS_END, n_in, ws_size); grid = -1; return; }
        int dev = 0, cus = 0, per_cu = 0;
        hipGetDevice(&dev); hipDeviceGetAttribute(&cus, hipDeviceAttributeMultiprocessorCount, dev);
        if (hipFuncSetAttribute((const void*)mega_fwd, hipFuncAttributeMaxDynamicSharedMemorySize, LDS_BYTES) != hipSuccess) { fprintf(stderr, "kernel_launch: hipFuncSetAttribute failed\n"); grid = -1; return; }
        if (hipOccupancyMaxActiveBlocksPerMultiprocessor(&per_cu, (const void*)mega_fwd, 512, LDS_BYTES) != hipSuccess || per_cu < 1) { fprintf(stderr, "kernel_launch: occupancy query says %d blocks per CU\n", per_cu); per_cu = 1; }
        (void)hipGetLastError();
        grid = cus;
    }
    if (grid < 0) return;
    hipMemsetAsync(d_ws, 0, WS_ZERO_BYTES, stream);
    Params p{};
    const float** pp = (const float**)&p;
    for (int i = 0; i < 19; ++i) pp[i] = (const float*)d_in[i];
    p.out = (float*)d_out; p.ws = (unsigned char*)d_ws;
    hipLaunchKernelGGL(mega_fwd, dim3(grid), dim3(512), LDS_BYTES, stream, p);
    const hipError_t e = hipPeekAtLastError();
    if (e != hipSuccess) fprintf(stderr, "kernel_launch: launch failed: %s (grid %d)\n", hipGetErrorString(e), grid);
}
```

```cpp
#define DIAG_SIMPLE_MOD 0
#define DIAG_SIMPLE_STATS 0
#include <hip/hip_runtime.h>
#include <cstdio>

#define LAS __attribute__((address_space(3)))
typedef unsigned short bf16_t;
typedef short bf16x8 __attribute__((ext_vector_type(8)));
typedef float f32x4 __attribute__((ext_vector_type(4)));
typedef float f32x16 __attribute__((ext_vector_type(16)));
typedef unsigned u32x4 __attribute__((ext_vector_type(4)));
typedef unsigned u32x2 __attribute__((ext_vector_type(2)));

constexpr int D = 1024, NBATCH = 8, SEQ = 2048, NS = 128, TS = 4;
constexpr int MP = NBATCH * SEQ, MS = NS * TS, M = MP + MS;
constexpr int NPROJ = 9216, NSEQ = NBATCH + NS;
constexpr float LN_EPS = 1e-5f;
constexpr float ALPHA = 1.18920711500272f;
constexpr size_t OUT_CONVP = (size_t)M * D, OUT_CONVS = OUT_CONVP + (size_t)NBATCH * 2 * D, OUT_CV = OUT_CONVS + (size_t)NS * 2 * D;
constexpr size_t MiB = 1u << 20;
constexpr size_t WS_STATS = 128 * 1024;
constexpr size_t WS_MOD = 1 * MiB;
constexpr size_t WS_ZERO_BYTES = 3 * MiB;
constexpr size_t WS_W1T = 3 * MiB;
constexpr size_t SLOT = (size_t)M * D * 2;
constexpr size_t WS_S0 = 21 * MiB;
constexpr size_t WS_H = WS_S0, WS_US = WS_S0 + SLOT, WS_V = WS_S0 + 2 * SLOT, WS_BS = WS_S0 + 3 * SLOT, WS_Z = WS_S0 + 4 * SLOT, WS_SGA = WS_S0 + 5 * SLOT, WS_SGB = WS_S0 + 6 * SLOT;
constexpr size_t WS_MG = WS_H;
constexpr size_t WS_END = WS_S0 + 7 * SLOT;
constexpr int LDS_BYTES = 147456;

struct Params {
    const float *x_prompt, *x_sample, *state_conv, *c_prompt, *c_sample, *w_c, *b_c, *w_in, *a_ln_g, *a_ln_b, *w_s, *b_s, *w_conv, *b_conv, *w_pa, *w_pb, *w_o, *ln_g, *ln_b;
    float* out; unsigned char* ws;
};

typedef __bf16 bf16x2_t __attribute__((ext_vector_type(2)));
typedef float f32x2_t __attribute__((ext_vector_type(2)));
__device__ __forceinline__ unsigned cvt_pk_bf16(float lo, float hi) { const f32x2_t v = {lo, hi}; const bf16x2_t b = __builtin_convertvector(v, bf16x2_t); return __builtin_bit_cast(unsigned, b); }
__device__ __forceinline__ float bf_lo(unsigned u) { return __uint_as_float(u << 16); }
__device__ __forceinline__ float bf_hi(unsigned u) { return __uint_as_float(u & 0xffff0000u); }
__device__ __forceinline__ float sigmoidf_(float x) { return __builtin_amdgcn_rcpf(1.0f + __expf(-x)); }
__device__ __forceinline__ float siluf_(float x) { return x * sigmoidf_(x); }
__device__ __forceinline__ float wave_sum(float v) {
#pragma unroll
    for (int o = 1; o < 64; o <<= 1) v += __shfl_xor(v, o);
    return v;
}

namespace pg8 {
constexpr int BM = 256, BK = 64, HALF = 128, HTB = HALF * BK * 2, STAGE_BYTES = 8 * HTB, NXCD = 8, WGM = 8;
__device__ __forceinline__ int lds_byte(int r, int c) { const int st = (r >> 4) * 2 + (c >> 5), rr = r & 15, cc = c & 31, ob = rr * 64 + cc * 2; return st * 1024 + (ob ^ (((ob >> 9) & 1) << 5)); }
__device__ __forceinline__ void stage_rc(int b, int& R, int& C) { const int st = b / 1024, sb = b % 1024, swz = sb ^ (((sb >> 9) & 1) << 5); R = (st >> 1) * 16 + swz / 64; C = (st & 1) * 32 + (swz % 64) / 2; }
__device__ __forceinline__ int perm32(int rho) { const int n = rho >> 4, i = rho & 15; return 8 * (i >> 2) + 4 * n + (i & 3); }

struct Unit { int pm, pn, half; };
struct GemmOp { const bf16_t* A0; const bf16_t* B0; const bf16_t* A1; const bf16_t* B1; int lda, ldb, nt; };

struct StaticOrder {
    int nM, nN, nwg, G, c;
    __device__ void init(int M_, int N_, int G_, int c_) { nM = M_ / BM; nN = N_ / BM; nwg = nM * nN; G = G_; c = c_; }
    __device__ __forceinline__ bool next(int i, Unit& u) const {
        const long L = (long)i * G + c; if (L >= nwg) return false;
        int wgid = (int)L; { const int q = nwg / NXCD, r = nwg % NXCD, xcd = wgid % NXCD, off = wgid / NXCD; wgid = (xcd < r ? xcd * (q + 1) : r * (q + 1) + (xcd - r) * q) + off; }
        const int nig = WGM * nN, gid = wgid / nig, fm = gid * WGM, gsz = (nM - fm) < WGM ? (nM - fm) : WGM;
        u.pm = fm + ((wgid % nig) % gsz); u.pn = (wgid % nig) / gsz; u.half = 0; return true;
    }
};
struct PairOrder {
    StaticOrder so;
    __device__ __forceinline__ bool next(int i, Unit& u) const { if (!so.next(i >> 1, u)) return false; u.half = i & 1; return true; }
};

template <class Epi, class Sched>
__device__ __forceinline__ void gemm_phase(LAS unsigned char* lds, const GemmOp g, const Sched& S, const Epi& E) {
    int tid = threadIdx.x; asm volatile("" : "+v"(tid));
    const int wid = __builtin_amdgcn_readfirstlane(tid >> 6), lane = tid & 63, wr = wid >> 2, wc = wid & 3, fr = lane & 15, fq = lane >> 4;
    const int nt = g.nt;
    unsigned voffA[2], voffB[2];
#pragma unroll
    for (int i = 0; i < 2; ++i) { int R, C; stage_rc(tid * 16 + i * 8192, R, C); const int Rb = Epi::PERM ? ((R & ~31) + perm32(R & 31)) : R;
        voffA[i] = (unsigned)(R * g.lda + C) * 2u; voffB[i] = (unsigned)(Rb * g.ldb + C) * 2u; }
    const size_t kstep = (size_t)(BK * 2);
    const size_t hstepA = (size_t)HALF * g.lda * 2, hstepB = (size_t)HALF * g.ldb * 2;
    const size_t tstepA = 2 * hstepA, tstepB = 2 * hstepB;
    const unsigned ldsw = (unsigned)wid * 1024u;
    const int aoff = lds_byte(wr * 64 + fr, fq * 8), boff = lds_byte(wc * 32 + fr, fq * 8);
#define PG8_SA(b, h) (((b) * 2 + (h)) * HTB)
#define PG8_SB(b, h) ((4 + (b) * 2 + (h)) * HTB)
#define PG8_STAGE(bufoff, gbase, voff) do { _Pragma("unroll") for (int _i = 0; _i < 2; ++_i) \
        __builtin_amdgcn_global_load_lds((const unsigned*)((const char*)(gbase) + (voff)[_i]), (LAS unsigned*)(lds + (bufoff) + ldsw + _i * 8192), 16, 0, 0); } while (0)
#define PG8_LDA(dst, b, h) do { _Pragma("unroll") for (int m = 0; m < 4; ++m) _Pragma("unroll") for (int k = 0; k < 2; ++k) dst[m][k] = *(const LAS bf16x8*)(lds + PG8_SA(b, h) + aoff + m * 2048 + k * 1024); } while (0)
#define PG8_LDB(dst, b, h) do { _Pragma("unroll") for (int n = 0; n < 2; ++n) _Pragma("unroll") for (int k = 0; k < 2; ++k) dst[n][k] = *(const LAS bf16x8*)(lds + PG8_SB(b, h) + boff + n * 2048 + k * 1024); } while (0)
#define PG8_MMA(ai, bj, At, Bt) do { __builtin_amdgcn_s_setprio(1); _Pragma("unroll") for (int m = 0; m < 4; ++m) _Pragma("unroll") for (int n = 0; n < 2; ++n) _Pragma("unroll") for (int k = 0; k < 2; ++k) \
        acc[ai][bj][m][n] = __builtin_amdgcn_mfma_f32_16x16x32_bf16(Bt[n][k], At[m][k], acc[ai][bj][m][n], 0, 0, 0); __builtin_amdgcn_s_setprio(0); } while (0)
#define PG8_WAIT_V(n) asm volatile("s_waitcnt vmcnt(" #n ")" ::: "memory")
#define PG8_WAIT_L(n) asm volatile("s_waitcnt lgkmcnt(" #n ")" ::: "memory")
#define PG8_BAR __builtin_amdgcn_s_barrier()
#define PG8_SCHED __builtin_amdgcn_sched_barrier(0)
    Unit cur, nxt; int ui = 0;
    if (!S.next(0, cur)) return;
    f32x4 acc[2][2][4][2];
#pragma unroll
    for (int a = 0; a < 2; ++a)
#pragma unroll
        for (int b = 0; b < 2; ++b)
#pragma unroll
            for (int m = 0; m < 4; ++m)
#pragma unroll
                for (int n = 0; n < 2; ++n) acc[a][b][m][n] = (f32x4){0.f, 0.f, 0.f, 0.f};
    bf16x8 At[4][2], B0[2][2], B1[2][2];
    const char* cA = (const char*)(cur.half ? g.A1 : g.A0) + (size_t)cur.pm * tstepA; const char* cB = (const char*)(cur.half ? g.B1 : g.B0) + (size_t)cur.pn * tstepB;
    PG8_STAGE(PG8_SB(0, 0), cB, voffB); PG8_STAGE(PG8_SA(0, 0), cA, voffA); PG8_STAGE(PG8_SB(0, 1), cB + hstepB, voffB); PG8_STAGE(PG8_SA(0, 1), cA + hstepA, voffA);
    if (wr == 1) PG8_BAR;
    PG8_WAIT_V(4); PG8_BAR;
    PG8_STAGE(PG8_SB(1, 0), cB + kstep, voffB); PG8_STAGE(PG8_SA(1, 0), cA + kstep, voffA); PG8_STAGE(PG8_SB(1, 1), cB + hstepB + kstep, voffB);
    PG8_WAIT_V(6); PG8_BAR;
    for (;;) {
        const bool has_next = S.next(ui + 1, nxt);
        const char* nA = has_next ? (const char*)(nxt.half ? g.A1 : g.A0) + (size_t)nxt.pm * tstepA : cA; const char* nB = has_next ? (const char*)(nxt.half ? g.B1 : g.B0) + (size_t)nxt.pn * tstepB : cB;
        for (int t = 0; t < nt; t += 2) {
            const bool last = (t == nt - 2);
            const char* a1 = cA + (size_t)(t + 1) * kstep;
            const char* a2 = last ? nA : cA + (size_t)(t + 2) * kstep; const char* b2 = last ? nB : cB + (size_t)(t + 2) * kstep;
            const char* a3 = a2 + kstep; const char* b3 = b2 + kstep;
            PG8_LDB(B0, 0, 0); PG8_SCHED; PG8_LDA(At, 0, 0); PG8_STAGE(PG8_SA(1, 1), a1 + hstepA, voffA);
            PG8_WAIT_L(8); PG8_BAR; PG8_WAIT_L(0); PG8_MMA(0, 0, At, B0); PG8_BAR; PG8_SCHED;
            PG8_LDB(B1, 0, 1); PG8_STAGE(PG8_SB(0, 0), b2, voffB);
            PG8_BAR; PG8_WAIT_L(0); PG8_MMA(0, 1, At, B1); PG8_BAR;
            PG8_LDA(At, 0, 1); PG8_STAGE(PG8_SA(0, 0), a2, voffA);
            PG8_BAR; PG8_WAIT_L(0); PG8_MMA(1, 0, At, B0); PG8_BAR; PG8_SCHED;
            PG8_STAGE(PG8_SB(0, 1), b2 + hstepB, voffB);
            PG8_WAIT_V(6); PG8_BAR; PG8_MMA(1, 1, At, B1); PG8_BAR;
            PG8_LDB(B0, 1, 0); PG8_SCHED; PG8_LDA(At, 1, 0); PG8_STAGE(PG8_SA(0, 1), a2 + hstepA, voffA);
            PG8_WAIT_L(8); PG8_BAR; PG8_WAIT_L(0); PG8_MMA(0, 0, At, B0); PG8_BAR; PG8_SCHED;
            PG8_LDB(B1, 1, 1); PG8_STAGE(PG8_SB(1, 0), b3, voffB);
            PG8_BAR; PG8_WAIT_L(0); PG8_MMA(0, 1, At, B1); PG8_BAR;
            PG8_LDA(At, 1, 1); PG8_STAGE(PG8_SA(1, 0), a3, voffA);
            PG8_BAR; PG8_WAIT_L(0); PG8_MMA(1, 0, At, B0); PG8_BAR; PG8_SCHED;
            PG8_STAGE(PG8_SB(1, 1), b3 + hstepB, voffB);
            PG8_WAIT_V(6); PG8_BAR; PG8_MMA(1, 1, At, B1); PG8_BAR;
        }
        E(acc, cur, wr, wc, fr, fq);
        if (!has_next) break;
        cur = nxt; cA = nA; cB = nB; ++ui;
    }
    PG8_WAIT_V(0);
    if (wr == 0) PG8_BAR;
    PG8_BAR;
#undef PG8_SA
#undef PG8_SB
#undef PG8_STAGE
#undef PG8_LDA
#undef PG8_LDB
#undef PG8_MMA
#undef PG8_WAIT_V
#undef PG8_WAIT_L
#undef PG8_BAR
#undef PG8_SCHED
}
}

__device__ __forceinline__ void zero_acc(f32x4 (&acc)[2][2][4][2]) {
#pragma unroll
    for (int a = 0; a < 2; ++a)
#pragma unroll
        for (int b = 0; b < 2; ++b)
#pragma unroll
            for (int m = 0; m < 4; ++m)
#pragma unroll
                for (int n = 0; n < 2; ++n) acc[a][b][m][n] = (f32x4){0.f, 0.f, 0.f, 0.f};
}

struct Epi1 {
    static constexpr bool PERM = true;
    unsigned char* s0; float* stats;
    __device__ __forceinline__ void operator()(f32x4 (&acc)[2][2][4][2], const pg8::Unit& u, int wr, int wc, int fr, int fq) const {
        const int pn = u.pn, row0 = u.pm * 256 + wr * 64 + fr;
        if (pn < 8 || pn >= 12) {
            int slot, idx, mode;
            if (pn < 8) { slot = 1; idx = pn; mode = 0; } else if (pn < 20) { slot = 3; idx = pn - 12; mode = 0; } else if (pn < 28) { slot = 4; idx = pn - 20; mode = 1; } else { slot = 5; idx = pn - 28; mode = 2; }
            bf16_t* O = (bf16_t*)(s0 + (size_t)slot * SLOT);
            const int col0 = idx * 128 + wc * 32 + fq * 8;
#pragma unroll
            for (int ai = 0; ai < 2; ++ai)
#pragma unroll
                for (int m = 0; m < 4; ++m) {
                    bf16_t* rowp = O + (size_t)(row0 + ai * 128 + m * 16) * D + col0;
                    f32x4 r0, r1; const f32x4 a0 = acc[ai][0][m][0], a1 = acc[ai][0][m][1], b0 = acc[ai][1][m][0], b1 = acc[ai][1][m][1];
                    if (mode == 0) {
#pragma unroll
                        for (int j = 0; j < 4; ++j) { r0[j] = a0[j] * siluf_(b0[j]); r1[j] = a1[j] * siluf_(b1[j]); }
                    } else if (mode == 1) { r0 = a0 * b0; r1 = a1 * b1; }
                    else {
                        f32x4 s0v, s1v;
#pragma unroll
                        for (int j = 0; j < 4; ++j) { const float ea0 = 1.0f + __expf(-a0[j]), eb0 = 1.0f + __expf(-b0[j]), ea1 = 1.0f + __expf(-a1[j]), eb1 = 1.0f + __expf(-b1[j]);
                            r0[j] = eb0 * __builtin_amdgcn_rcpf(ea0); r1[j] = eb1 * __builtin_amdgcn_rcpf(ea1); s0v[j] = __builtin_amdgcn_rcpf(eb0); s1v[j] = __builtin_amdgcn_rcpf(eb1); }
                        u32x4 w2; w2.x = cvt_pk_bf16(s0v[0], s0v[1]); w2.y = cvt_pk_bf16(s0v[2], s0v[3]); w2.z = cvt_pk_bf16(s1v[0], s1v[1]); w2.w = cvt_pk_bf16(s1v[2], s1v[3]);
                        *(u32x4*)((char*)rowp + SLOT) = w2;
                    }
                    u32x4 w; w.x = cvt_pk_bf16(r0[0], r0[1]); w.y = cvt_pk_bf16(r0[2], r0[3]); w.z = cvt_pk_bf16(r1[0], r1[1]); w.w = cvt_pk_bf16(r1[2], r1[3]);
                    *(u32x4*)rowp = w;
                }
        } else {
            bf16_t* O = (bf16_t*)(s0 + (size_t)2 * SLOT);
            const int col0 = (pn - 8) * 256 + wc * 32 + fq * 8;
#pragma unroll
            for (int ai = 0; ai < 2; ++ai)
#pragma unroll
                for (int m = 0; m < 4; ++m) {
                    const int row = row0 + ai * 128 + m * 16;
                    bf16_t* rowp = O + (size_t)row * D + col0;
                    float s = 0.f, q = 0.f;
#pragma unroll
                    for (int bj = 0; bj < 2; ++bj) {
                        const f32x4 r0 = acc[ai][bj][m][0], r1 = acc[ai][bj][m][1];
#pragma unroll
                        for (int j = 0; j < 4; ++j) { s += r0[j] + r1[j]; q += r0[j] * r0[j] + r1[j] * r1[j]; }
                        u32x4 w; w.x = cvt_pk_bf16(r0[0], r0[1]); w.y = cvt_pk_bf16(r0[2], r0[3]); w.z = cvt_pk_bf16(r1[0], r1[1]); w.w = cvt_pk_bf16(r1[2], r1[3]);
                        *(u32x4*)(rowp + bj * 128) = w;
                    }
                    s += __shfl_xor(s, 16); s += __shfl_xor(s, 32); q += __shfl_xor(q, 16); q += __shfl_xor(q, 32);
                    if (fq == 0) { atomicAdd(stats + 2 * row, s); atomicAdd(stats + 2 * row + 1, q); }
                }
        }
        zero_acc(acc);
    }
};

#define G2_LD(o, v, s, imm) "global_load_dwordx4 %" #o ", %" #v ", %" #s " offset:" #imm "\n\t"
#define G2_ST(v, d, s, imm) "global_store_dwordx4 %" #v ", %" #d ", %" #s " offset:" #imm "\n\t"
struct Epi2 {
    static constexpr bool PERM = true;
    const bf16_t *RT, *SGB; bf16_t* MG;
    __device__ __forceinline__ void operator()(f32x4 (&acc)[2][2][4][2], const pg8::Unit& u, int wr, int wc, int fr, int fq) const {
        const unsigned l0 = (unsigned)(fr * D + wc * 32 + fq * 8) * 2u, l1 = l0 + 16 * D * 2;
        const size_t tb = ((size_t)(u.pm * 256 + wr * 64) * D + (size_t)u.pn * 256) * 2;
        const char* src = (const char*)(u.half == 0 ? RT : SGB) + tb;
#pragma unroll
        for (int ai = 0; ai < 2; ++ai)
#pragma unroll
            for (int mh = 0; mh < 2; ++mh) {
                const size_t rb = (size_t)(ai * 128 + mh * 32) * D * 2;
                const char* pg = src + rb;
                u32x4 gv[2][2];
                asm volatile(G2_LD(0, 4, 6, 0) G2_LD(1, 4, 6, 256) G2_LD(2, 5, 6, 0) G2_LD(3, 5, 6, 256)
                             "s_waitcnt vmcnt(0)"
                             : "=&v"(gv[0][0]), "=&v"(gv[0][1]), "=&v"(gv[1][0]), "=&v"(gv[1][1])
                             : "v"(l0), "v"(l1), "s"(pg) : "memory");
#pragma unroll
                for (int mm = 0; mm < 2; ++mm)
#pragma unroll
                    for (int bj = 0; bj < 2; ++bj) {
                        const int m = 2 * mh + mm; const u32x4 b = gv[mm][bj];
                        acc[ai][bj][m][0] *= (f32x4){bf_lo(b.x), bf_hi(b.x), bf_lo(b.y), bf_hi(b.y)};
                        acc[ai][bj][m][1] *= (f32x4){bf_lo(b.z), bf_hi(b.z), bf_lo(b.w), bf_hi(b.w)};
                    }
                if (u.half != 0) {
                    char* po = (char*)MG + tb + rb;
                    u32x4 w[2][2];
#pragma unroll
                    for (int mm = 0; mm < 2; ++mm)
#pragma unroll
                        for (int bj = 0; bj < 2; ++bj) {
                            const int m = 2 * mh + mm; const f32x4 a0 = acc[ai][bj][m][0], a1 = acc[ai][bj][m][1];
                            w[mm][bj].x = cvt_pk_bf16(a0[0], a0[1]); w[mm][bj].y = cvt_pk_bf16(a0[2], a0[3]); w[mm][bj].z = cvt_pk_bf16(a1[0], a1[1]); w[mm][bj].w = cvt_pk_bf16(a1[2], a1[3]);
                        }
                    asm volatile(G2_ST(4, 0, 6, 0) G2_ST(4, 1, 6, 256) G2_ST(5, 2, 6, 0) G2_ST(5, 3, 6, 256)
                                 "s_nop 1"
                                 :: "v"(w[0][0]), "v"(w[0][1]), "v"(w[1][0]), "v"(w[1][1]), "v"(l0), "v"(l1), "s"(po) : "memory");
                }
            }
        if (u.half != 0) zero_acc(acc);
    }
};

struct Epi3 {
    static constexpr bool PERM = false;
    const float *x_prompt, *x_sample, *mod; float* out;
    __device__ __forceinline__ void operator()(f32x4 (&acc)[2][2][4][2], const pg8::Unit& u, int wr, int wc, int fr, int fq) const {
        const int lrow0 = wr * 64 + fr, col0 = u.pn * 256 + wc * 32 + 4 * fq;
        const bool prompt = u.pm < 64;
        const float* xb = prompt ? x_prompt + (size_t)u.pm * 256 * D : x_sample + (size_t)(u.pm - 64) * 256 * D;
#pragma unroll
        for (int ai = 0; ai < 2; ++ai)
#pragma unroll
            for (int m = 0; m < 4; ++m) {
                const int lr = lrow0 + ai * 128 + m * 16;
                const int sq = prompt ? (u.pm >> 3) : (NBATCH + (((u.pm - 64) * 256 + lr) >> 2));
                const float* gp = mod + (size_t)sq * 3072 + 2048 + col0;
                const float* xp = xb + (size_t)lr * D + col0;
                float* op = out + ((size_t)u.pm * 256 + lr) * D + col0;
#pragma unroll
                for (int bj = 0; bj < 2; ++bj)
#pragma unroll
                    for (int n = 0; n < 2; ++n) {
                        const f32x4 gv = *(const f32x4*)(gp + bj * 128 + n * 16), xv = *(const f32x4*)(xp + bj * 128 + n * 16);
                        *(f32x4*)(op + bj * 128 + n * 16) = xv * ALPHA + (gv + 1.0f) * acc[ai][bj][m][n];
                    }
            }
        zero_acc(acc);
    }
};

__device__ __forceinline__ int src_col(int n) {
    const int t = n >> 8, r = n & 255;
    if (t < 8) return r < 128 ? 128 * t + r : 2048 + 128 * t + (r - 128);
    if (t < 12) return 1024 + 256 * (t - 8) + r;
    if (t < 20) return r < 128 ? 3072 + 128 * (t - 12) + r : 6144 + 128 * (t - 12) + (r - 128);
    if (t < 28) return r < 128 ? 4096 + 128 * (t - 20) + r : 5120 + 128 * (t - 20) + (r - 128);
    return r < 128 ? 7168 + 128 * (t - 28) + r : 8192 + 128 * (t - 28) + (r - 128);
}
__device__ __forceinline__ void transpose_item(const float* W, int ldw, int srccol0, bf16_t* WT, int ldt, int dstrow0, int k0, LAS float* scr, int lane) {
#pragma unroll 8
    for (int i = 0; i < 32; ++i) { const int kk = 2 * i + (lane >> 5); scr[kk * 33 + (lane & 31)] = W[(size_t)(k0 + kk) * ldw + srccol0 + (lane & 31)]; }
    asm volatile("s_waitcnt lgkmcnt(0)" ::: "memory");
    const int c = lane & 7;
#pragma unroll
    for (int j = 0; j < 4; ++j) { const int n = (lane >> 3) + 8 * j; const LAS float* s = scr + (8 * c) * 33 + n;
        u32x4 o; o.x = cvt_pk_bf16(s[0 * 33], s[1 * 33]); o.y = cvt_pk_bf16(s[2 * 33], s[3 * 33]); o.z = cvt_pk_bf16(s[4 * 33], s[5 * 33]); o.w = cvt_pk_bf16(s[6 * 33], s[7 * 33]);
        *(u32x4*)(WT + (size_t)(dstrow0 + n) * ldt + k0 + 8 * c) = o; }
    asm volatile("s_waitcnt lgkmcnt(0)" ::: "memory");
}

__device__ __forceinline__ void phase0(const Params& p, LAS unsigned char* lds, int wave, int lane) {
    const int gw = blockIdx.x * 8 + wave, NGW = gridDim.x * 8;
    float* mod = (float*)(p.ws + WS_MOD);
#if DIAG_SIMPLE_MOD
    for (int o = blockIdx.x * 512 + threadIdx.x; o < NSEQ * 3072; o += gridDim.x * 512) {
        const int row = o / 3072, col = o % 3072;
        const float* cr = row < NBATCH ? p.c_prompt + (size_t)row * D : p.c_sample + (size_t)(row - NBATCH) * D;
        float s = 0.f;
        for (int k = 0; k < D; ++k) s += cr[k] * p.w_c[(size_t)k * 3072 + col];
        mod[o] = s + p.b_c[col];
    }
    for (int task = gw; task < 0; task += NGW) {
#else
    for (int task = gw; task < 5 * 96 * 4; task += NGW) {
#endif
        const int ks = task & 3, ob = task >> 2, rb = ob / 96, cb = ob % 96, h = lane >> 5;
        int arow = 32 * rb + (lane & 31); if (arow > NSEQ - 1) arow = NSEQ - 1;
        const float* ap = (arow < NBATCH ? p.c_prompt + (size_t)arow * D : p.c_sample + (size_t)(arow - NBATCH) * D) + 256 * ks + 128 * h;
        const float* bp = p.w_c + (size_t)(256 * ks + 128 * h) * 3072 + 32 * cb + (lane & 31);
        f32x16 acc;
#pragma unroll
        for (int r = 0; r < 16; ++r) acc[r] = 0.f;
#pragma unroll 1
        for (int i0 = 0; i0 < 128; i0 += 8, ap += 8, bp += 8 * 3072) {
            const f32x4 a0 = *(const f32x4*)ap, a1 = *(const f32x4*)(ap + 4);
            float b[8];
#pragma unroll
            for (int e = 0; e < 8; ++e) b[e] = bp[(size_t)e * 3072];
#pragma unroll
            for (int e = 0; e < 4; ++e) acc = __builtin_amdgcn_mfma_f32_32x32x2f32(a0[e], b[e], acc, 0, 0, 0);
#pragma unroll
            for (int e = 0; e < 4; ++e) acc = __builtin_amdgcn_mfma_f32_32x32x2f32(a1[e], b[4 + e], acc, 0, 0, 0);
        }
        const int col = 32 * cb + (lane & 31); const float bias = (ks == 0) ? p.b_c[col] : 0.f;
#pragma unroll
        for (int r = 0; r < 16; ++r) { const int row = 32 * rb + (r & 3) + 8 * (r >> 2) + 4 * h; if (row < NSEQ) atomicAdd(mod + (size_t)row * 3072 + col, acc[r] + bias); }
    }
    LAS float* scr = (LAS float*)(lds + wave * 16384);
    bf16_t* W1T = (bf16_t*)(p.ws + WS_W1T);
    for (int it = gw; it < 16 * 288; it += NGW) { const int kb = it / 288, nb = it % 288; transpose_item(p.w_in, NPROJ, src_col(32 * nb), W1T, D, 32 * nb, 64 * kb, scr, lane); }
}

__device__ __forceinline__ void phase1(const Params& p) {
    const float* mod = (const float*)(p.ws + WS_MOD); bf16_t* H = (bf16_t*)(p.ws + WS_H);
    const int nth = gridDim.x * 512;
    for (int it = blockIdx.x * 512 + threadIdx.x; it < M * 128; it += nth) {
        const int row = it >> 7, c8 = (it & 127) * 8;
        const float* xr = (row < MP ? p.x_prompt + (size_t)row * D : p.x_sample + (size_t)(row - MP) * D) + c8;
        const int sq = row < MP ? (row >> 11) : NBATCH + ((row - MP) >> 2);
        const float* mr = mod + (size_t)sq * 3072 + c8;
        const f32x4 x0 = *(const f32x4*)xr, x1 = *(const f32x4*)(xr + 4), sh0 = *(const f32x4*)mr, sh1 = *(const f32x4*)(mr + 4), sc0 = *(const f32x4*)(mr + 1024), sc1 = *(const f32x4*)(mr + 1028);
        const f32x4 h0 = x0 * (sc0 + 1.0f) + sh0, h1 = x1 * (sc1 + 1.0f) + sh1;
        u32x4 w; w.x = cvt_pk_bf16(h0[0], h0[1]); w.y = cvt_pk_bf16(h0[2], h0[3]); w.z = cvt_pk_bf16(h1[0], h1[1]); w.w = cvt_pk_bf16(h1[2], h1[3]);
        *(u32x4*)(H + (size_t)row * D + c8) = w;
    }
}

__device__ __forceinline__ void unpack8(const u32x4 r, float (&f)[8]) { f[0] = bf_lo(r.x); f[1] = bf_hi(r.x); f[2] = bf_lo(r.y); f[3] = bf_hi(r.y); f[4] = bf_lo(r.z); f[5] = bf_hi(r.z); f[6] = bf_lo(r.w); f[7] = bf_hi(r.w); }

__device__ __forceinline__ void phase3(const Params& p, LAS unsigned char* lds, int wave, int lane) {
    const int tid = threadIdx.x;
    bf16_t* US = (bf16_t*)(p.ws + WS_US); const bf16_t* V = (const bf16_t*)(p.ws + WS_V); bf16_t* BS = (bf16_t*)(p.ws + WS_BS); const bf16_t* Z = (const bf16_t*)(p.ws + WS_Z);
#if DIAG_SIMPLE_STATS
    const float* stats = (const float*)(p.ws + WS_STATS + 512 * 1024);
#else
    const float* stats = (const float*)(p.ws + WS_STATS);
#endif
    constexpr int LS = 136;
    LAS bf16_t* Wl = (LAS bf16_t*)lds;
    LAS bf16_t* Vl = Wl + 128 * LS;
    for (int unit = blockIdx.x; unit < 1024; unit += gridDim.x) {
        const int c = unit >> 3, g = unit & 7, r0 = 128 * c;
        __syncthreads();
        for (int q = tid; q < 2048; q += 512) {
            const int t = q >> 4, j8 = (q & 15) * 8; const float* wp = p.w_s + ((size_t)(g * 128 + t) * 128 + j8);
            f32x4 w0 = *(const f32x4*)wp, w1 = *(const f32x4*)(wp + 4);
#pragma unroll
            for (int e = 0; e < 4; ++e) { if (j8 + e > t) w0[e] = 0.f; if (j8 + 4 + e > t) w1[e] = 0.f; }
            u32x4 o; o.x = cvt_pk_bf16(w0[0], w0[1]); o.y = cvt_pk_bf16(w0[2], w0[3]); o.z = cvt_pk_bf16(w1[0], w1[1]); o.w = cvt_pk_bf16(w1[2], w1[3]);
            *(LAS u32x4*)(Wl + t * LS + j8) = o;
        }
        {
            const int jb = tid >> 4, c8 = (tid & 15) * 8, ch = 128 * g + c8;
            float gam[8], bet[8];
            { const f32x4 g0 = *(const f32x4*)(p.a_ln_g + ch), g1 = *(const f32x4*)(p.a_ln_g + ch + 4), b0 = *(const f32x4*)(p.a_ln_b + ch), b1 = *(const f32x4*)(p.a_ln_b + ch + 4);
#pragma unroll
              for (int e = 0; e < 4; ++e) { gam[e] = g0[e]; gam[4 + e] = g1[e]; bet[e] = b0[e]; bet[4 + e] = b1[e]; } }
            float f[4][8];
#pragma unroll
            for (int e = 0; e < 4; ++e) {
                const int row = r0 + 4 * jb + e;
                const u32x4 raw = *(const u32x4*)(V + (size_t)row * D + ch);
                const float sm = stats[2 * row], sq = stats[2 * row + 1];
                const float mu = sm * (1.0f / D), var = fmaxf(sq * (1.0f / D) - mu * mu, 0.f), rstd = 1.0f / sqrtf(var + LN_EPS);
                float x[8]; unpack8(raw, x);
#pragma unroll
                for (int k = 0; k < 8; ++k) f[e][k] = (x[k] - mu) * rstd * gam[k] + bet[k];
            }
#pragma unroll
            for (int k = 0; k < 8; ++k) { u32x2 o; o.x = cvt_pk_bf16(f[0][k], f[1][k]); o.y = cvt_pk_bf16(f[2][k], f[3][k]); *(LAS u32x2*)(Vl + (c8 + k) * LS + 4 * jb) = o; }
        }
        __syncthreads();
        {
            const int fr = lane & 15, fq = lane >> 4, nks = ((16 * wave + 15) >> 5) + 1;
            f32x4 acc[8];
#pragma unroll
            for (int nb = 0; nb < 8; ++nb) acc[nb] = (f32x4){0.f, 0.f, 0.f, 0.f};
            for (int ks = 0; ks < nks; ++ks) {
                const bf16x8 bw = *(const LAS bf16x8*)(Wl + (16 * wave + fr) * LS + 32 * ks + 8 * fq);
#pragma unroll
                for (int nb = 0; nb < 8; ++nb) { const bf16x8 av = *(const LAS bf16x8*)(Vl + (16 * nb + fr) * LS + 32 * ks + 8 * fq); acc[nb] = __builtin_amdgcn_mfma_f32_16x16x32_bf16(av, bw, acc[nb], 0, 0, 0); }
            }
            const int t = 16 * wave + fr, row = r0 + t; const float bsv = p.b_s[g * 128 + t];
#pragma unroll
            for (int nb = 0; nb < 8; ++nb) {
                bf16_t* up = US + (size_t)row * D + 128 * g + 16 * nb + 4 * fq;
                const u32x2 uv = *(const u32x2*)up;
                u32x2 o; o.x = cvt_pk_bf16(bf_lo(uv.x) * (acc[nb][0] + bsv), bf_hi(uv.x) * (acc[nb][1] + bsv)); o.y = cvt_pk_bf16(bf_lo(uv.y) * (acc[nb][2] + bsv), bf_hi(uv.y) * (acc[nb][3] + bsv));
                *(u32x2*)up = o;
            }
        }
    }
    __syncthreads();
    {
        const int gw = blockIdx.x * 8 + wave, NGW = gridDim.x * 8;
        LAS float* scr = (LAS float*)(lds + wave * 16384);
        bf16_t* WT = (bf16_t*)(p.ws + WS_W1T);
        for (int it = gw; it < 3 * 512; it += NGW) { const int w = it >> 9, r = it & 511, kb = r >> 5, nb = r & 31;
            const float* src = w == 0 ? p.w_pa : (w == 1 ? p.w_pb : p.w_o);
            transpose_item(src, D, 32 * nb, WT + (size_t)w * D * D, D, 32 * nb, 64 * kb, scr, lane); }
    }
    const int gt = blockIdx.x * 512 + tid, nth = gridDim.x * 512;
    for (int it = gt; it < NS * 128; it += nth) {
        const int n = it >> 7, c8 = (it & 127) * 8, g = c8 >> 7, rowb = MP + 4 * n;
        float gam[8], bet[8];
        { const f32x4 g0 = *(const f32x4*)(p.a_ln_g + c8), g1 = *(const f32x4*)(p.a_ln_g + c8 + 4), b0 = *(const f32x4*)(p.a_ln_b + c8), b1 = *(const f32x4*)(p.a_ln_b + c8 + 4);
#pragma unroll
          for (int e = 0; e < 4; ++e) { gam[e] = g0[e]; gam[4 + e] = g1[e]; bet[e] = b0[e]; bet[4 + e] = b1[e]; } }
        float f[4][8];
#pragma unroll
        for (int e = 0; e < 4; ++e) {
            const int row = rowb + e;
            const u32x4 raw = *(const u32x4*)(V + (size_t)row * D + c8);
            const float sm = stats[2 * row], sq = stats[2 * row + 1];
            const float mu = sm * (1.0f / D), var = fmaxf(sq * (1.0f / D) - mu * mu, 0.f), rstd = 1.0f / sqrtf(var + LN_EPS);
            float x[8]; unpack8(raw, x);
#pragma unroll
            for (int k = 0; k < 8; ++k) f[e][k] = (x[k] - mu) * rstd * gam[k] + bet[k];
            float* cv = p.out + OUT_CV + ((size_t)(4 * n + e)) * D + c8;
            *(f32x4*)cv = (f32x4){f[e][0], f[e][1], f[e][2], f[e][3]}; *(f32x4*)(cv + 4) = (f32x4){f[e][4], f[e][5], f[e][6], f[e][7]};
        }
#pragma unroll
        for (int t = 0; t < 4; ++t) {
            const f32x4 wr4 = *(const f32x4*)(p.w_s + ((size_t)(g * 128 + t) * 128)); const float bsv = p.b_s[g * 128 + t];
            bf16_t* up = US + (size_t)(rowb + t) * D + c8; const u32x4 uv = *(const u32x4*)up; float us[8]; unpack8(uv, us);
            float o[8];
#pragma unroll
            for (int k = 0; k < 8; ++k) { float s = bsv;
#pragma unroll
                for (int j = 0; j < 4; ++j) if (j <= t) s += wr4[j] * f[j][k];
                o[k] = us[k] * s; }
            u32x4 w; w.x = cvt_pk_bf16(o[0], o[1]); w.y = cvt_pk_bf16(o[2], o[3]); w.z = cvt_pk_bf16(o[4], o[5]); w.w = cvt_pk_bf16(o[6], o[7]);
            *(u32x4*)up = w;
        }
    }
    for (int it = gt; it < (M / 4) * 128; it += nth) {
        const int rb = it >> 7, c8 = (it & 127) * 8, row0 = 4 * rb;
        float w0[8], w1[8], w2[8], bc[8];
        { const f32x4 a0 = *(const f32x4*)(p.w_conv + c8), a1 = *(const f32x4*)(p.w_conv + c8 + 4), b0 = *(const f32x4*)(p.w_conv + D + c8), b1 = *(const f32x4*)(p.w_conv + D + c8 + 4),
                      c0 = *(const f32x4*)(p.w_conv + 2 * D + c8), c1 = *(const f32x4*)(p.w_conv + 2 * D + c8 + 4), d0 = *(const f32x4*)(p.b_conv + c8), d1 = *(const f32x4*)(p.b_conv + c8 + 4);
#pragma unroll
          for (int e = 0; e < 4; ++e) { w0[e] = a0[e]; w0[4 + e] = a1[e]; w1[e] = b0[e]; w1[4 + e] = b1[e]; w2[e] = c0[e]; w2[4 + e] = c1[e]; bc[e] = d0[e]; bc[4 + e] = d1[e]; } }
        float zm2[8], zm1[8];
        if (row0 >= MP) {
            const int n = (row0 - MP) >> 2; const float* st = p.state_conv + (size_t)n * 2 * D + c8;
            const f32x4 s0 = *(const f32x4*)st, s1 = *(const f32x4*)(st + 4), s2 = *(const f32x4*)(st + D), s3 = *(const f32x4*)(st + D + 4);
#pragma unroll
            for (int e = 0; e < 4; ++e) { zm2[e] = s0[e]; zm2[4 + e] = s1[e]; zm1[e] = s2[e]; zm1[4 + e] = s3[e]; }
        } else if ((row0 & (SEQ - 1)) == 0) {
#pragma unroll
            for (int k = 0; k < 8; ++k) { zm2[k] = 0.f; zm1[k] = 0.f; }
        } else {
            unpack8(*(const u32x4*)(Z + (size_t)(row0 - 2) * D + c8), zm2); unpack8(*(const u32x4*)(Z + (size_t)(row0 - 1) * D + c8), zm1);
        }
#pragma unroll
        for (int e = 0; e < 4; ++e) {
            const int row = row0 + e;
            float z0[8], b[8], o[8]; unpack8(*(const u32x4*)(Z + (size_t)row * D + c8), z0); unpack8(*(const u32x4*)(BS + (size_t)row * D + c8), b);
#pragma unroll
            for (int k = 0; k < 8; ++k) o[k] = b[k] * (bc[k] + w0[k] * zm2[k] + w1[k] * zm1[k] + w2[k] * z0[k]);
            u32x4 w; w.x = cvt_pk_bf16(o[0], o[1]); w.y = cvt_pk_bf16(o[2], o[3]); w.z = cvt_pk_bf16(o[4], o[5]); w.w = cvt_pk_bf16(o[6], o[7]);
            *(u32x4*)(BS + (size_t)row * D + c8) = w;
            float* dst = nullptr;
            if (row < MP) { const int tt = row & (SEQ - 1); if (tt >= SEQ - 2) dst = p.out + OUT_CONVP + ((size_t)(row >> 11) * 2 + (tt - (SEQ - 2))) * D + c8; }
            else { const int tt = (row - MP) & 3; if (tt >= 2) dst = p.out + OUT_CONVS + ((size_t)((row - MP) >> 2) * 2 + (tt - 2)) * D + c8; }
            if (dst) { *(f32x4*)dst = (f32x4){z0[0], z0[1], z0[2], z0[3]}; *(f32x4*)(dst + 4) = (f32x4){z0[4], z0[5], z0[6], z0[7]}; }
#pragma unroll
            for (int k = 0; k < 8; ++k) { zm2[k] = zm1[k]; zm1[k] = z0[k]; }
        }
    }
}

__device__ __forceinline__ void phase6(const Params& p, int wave, int lane) {
    const int gw = blockIdx.x * 8 + wave, NGW = gridDim.x * 8;
    f32x4 gv[4], bv[4];
#pragma unroll
    for (int j = 0; j < 4; ++j) { gv[j] = *((const f32x4*)p.ln_g + lane + 64 * j); bv[j] = *((const f32x4*)p.ln_b + lane + 64 * j); }
    for (int row = gw; row < M; row += NGW) {
        f32x4* xr = (f32x4*)(p.out + (size_t)row * D) + lane;
        f32x4 v[4]; float s = 0.f;
#pragma unroll
        for (int j = 0; j < 4; ++j) { v[j] = xr[64 * j]; s += (v[j].x + v[j].y) + (v[j].z + v[j].w); }
        const float mean = wave_sum(s) * (1.f / D); float s2 = 0.f;
#pragma unroll
        for (int j = 0; j < 4; ++j) { v[j] = v[j] - mean; s2 += (v[j].x * v[j].x + v[j].y * v[j].y) + (v[j].z * v[j].z + v[j].w * v[j].w); }
        const float rstd = 1.f / sqrtf(wave_sum(s2) * (1.f / D) + LN_EPS);
#pragma unroll
        for (int j = 0; j < 4; ++j) xr[64 * j] = v[j] * rstd * gv[j] + bv[j];
    }
}


#define XB_TMO      128
#define XB_XCNT(j)  (256  + 64 * (j))
#define XB_XSUB(j)  (1280 + 64 * (j))
#define XB_XGEN(j)  (2304 + 64 * (j))
#define XB_TOP      3328
#define XB_TOPGEN   3392
#define XCD_BAR_WORDS 3456
#define XB_SPIN_CAP (1u << 18)
__device__ __forceinline__ unsigned xb_ld(unsigned* p)              { return __hip_atomic_load(p, __ATOMIC_RELAXED, __HIP_MEMORY_SCOPE_AGENT); }
__device__ __forceinline__ unsigned xb_add(unsigned* p, unsigned v) { return __hip_atomic_fetch_add(p, v, __ATOMIC_RELAXED, __HIP_MEMORY_SCOPE_AGENT); }
__device__ __forceinline__ unsigned xb_xcc_id() { return (unsigned)__builtin_amdgcn_s_getreg((3 << 11) | 20) & 0xFu; }
#define XB_SPIN(cond, bar) do { unsigned _sp = 0; while (cond) { __builtin_amdgcn_s_sleep(1); \
    if ((++_sp & 255u) == 0u) { if (xb_ld(&(bar)[XB_TMO])) break; if (_sp > XB_SPIN_CAP) { atomicAdd(&(bar)[XB_TMO], 1u); break; } } } } while (0)
struct XcdBarrier { unsigned* bar; unsigned x; volatile LAS unsigned* st; };
__device__ __forceinline__ XcdBarrier xcd_barrier_post(unsigned* bar, volatile LAS unsigned* st) {
    XcdBarrier b; b.bar = bar; b.x = xb_xcc_id(); b.st = st;
    if (threadIdx.x == 0) (void)xb_add(&bar[XB_XCNT(b.x)], 1u);
    return b;
}
__device__ __forceinline__ void xcd_barrier_complete(unsigned* bar, unsigned x, unsigned& nloc, unsigned& nx) {
    const unsigned G = gridDim.x * gridDim.y * gridDim.z;
    unsigned sum, cnt, mine, sp = 0u;
    for (;;) {
        sum = 0u; cnt = 0u; mine = 0u;
#pragma unroll
        for (unsigned j = 0; j < 16; ++j) { const unsigned c = xb_ld(&bar[XB_XCNT(j)]); sum += c; cnt += (c > 0u) ? 1u : 0u; mine = (j == x) ? c : mine; }
        if (sum == G) break;
        __builtin_amdgcn_s_sleep(1);
        if ((++sp & 255u) == 0u) { if (xb_ld(&bar[XB_TMO])) break; if (sp > XB_SPIN_CAP) { atomicAdd(&bar[XB_TMO], 1u); break; } }
    }
    nloc = mine > 0u ? mine : 1u; nx = cnt > 0u ? cnt : 1u;
}
__device__ __forceinline__ void xcd_barrier(const XcdBarrier& b) {
    asm volatile("s_waitcnt vmcnt(0)" ::: "memory");
    __syncthreads();
    if (threadIdx.x == 0) {
        unsigned* bar = b.bar;
        __builtin_amdgcn_s_waitcnt(0);
        unsigned nloc = b.st[0], nx = b.st[1];
        if (nloc == 0u) { xcd_barrier_complete(bar, b.x, nloc, nx); b.st[0] = nloc; b.st[1] = nx; }
        const unsigned old = xb_add(&bar[XB_XSUB(b.x)], 1u);
        const unsigned gen = old / nloc;
        if (old + 1u == (gen + 1u) * nloc) {
            __builtin_amdgcn_fence(__ATOMIC_RELEASE, "agent");
            asm volatile("s_waitcnt vmcnt(0)" ::: "memory");
            const unsigned og = xb_add(&bar[XB_TOP], 1u);
            const unsigned tg = og / nx;
            if (og + 1u == (tg + 1u) * nx) xb_add(&bar[XB_TOPGEN], 1u);
            else XB_SPIN(xb_ld(&bar[XB_TOPGEN]) == tg, bar);
            __builtin_amdgcn_fence(__ATOMIC_ACQUIRE, "agent");
            xb_add(&bar[XB_XGEN(b.x)], 1u);
            asm volatile("s_waitcnt vmcnt(0)" ::: "memory");
        } else {
            XB_SPIN(xb_ld(&bar[XB_XGEN(b.x)]) == gen, bar);
            __builtin_amdgcn_fence(__ATOMIC_ACQUIRE, "agent");
            asm volatile("s_waitcnt vmcnt(0)" ::: "memory");
        }
    }
    __syncthreads();
}

__global__ void __launch_bounds__(512, 2) mega_fwd(Params p) {
    extern __shared__ __attribute__((aligned(16))) unsigned char lds_raw[];
    LAS unsigned char* lds = (LAS unsigned char*)lds_raw;
    const int tid = threadIdx.x, lane = tid & 63, wave = __builtin_amdgcn_readfirstlane(tid >> 6);
    const int G = gridDim.x, bid = blockIdx.x;
    volatile LAS unsigned* bst = (volatile LAS unsigned*)(lds + 131072 + 64);
    if (tid < 2) bst[tid] = 0u;
    __syncthreads();
    const XcdBarrier bar = xcd_barrier_post((unsigned*)p.ws, bst);
#define GRID_BAR() xcd_barrier(bar)

    phase0(p, lds, wave, lane);
    GRID_BAR();
    phase1(p);
    GRID_BAR();
    {
        pg8::GemmOp g{(const bf16_t*)(p.ws + WS_H), (const bf16_t*)(p.ws + WS_W1T), nullptr, nullptr, D, D, D / 64};
        pg8::StaticOrder S; S.init(M, NPROJ, G, bid);
        Epi1 E{p.ws + WS_S0, (float*)(p.ws + WS_STATS)};
        pg8::gemm_phase<Epi1, pg8::StaticOrder>(lds, g, S, E);
    }
    GRID_BAR();
#if DIAG_SIMPLE_STATS
    {
        float* st2 = (float*)(p.ws + WS_STATS + 512 * 1024); const bf16_t* V = (const bf16_t*)(p.ws + WS_V);
        for (int row = bid * 8 + wave; row < M; row += G * 8) {
            float s = 0.f, q = 0.f;
            for (int c = lane; c < D; c += 64) { const float x = __uint_as_float((unsigned)V[(size_t)row * D + c] << 16); s += x; q += x * x; }
            s = wave_sum(s); q = wave_sum(q);
            if (lane == 0) { st2[2 * row] = s; st2[2 * row + 1] = q; }
        }
    }
    GRID_BAR();
#endif
    phase3(p, lds, wave, lane);
    GRID_BAR();
    {
        const bf16_t* WT = (const bf16_t*)(p.ws + WS_W1T);
        pg8::GemmOp g{(const bf16_t*)(p.ws + WS_US), WT, (const bf16_t*)(p.ws + WS_BS), WT + (size_t)D * D, D, D, D / 64};
        pg8::PairOrder S; S.so.init(M, D, G, bid);
        Epi2 E{(const bf16_t*)(p.ws + WS_SGA), (const bf16_t*)(p.ws + WS_SGB), (bf16_t*)(p.ws + WS_MG)};
        pg8::gemm_phase<Epi2, pg8::PairOrder>(lds, g, S, E);
    }
    GRID_BAR();
    {
        const bf16_t* WT = (const bf16_t*)(p.ws + WS_W1T);
        pg8::GemmOp g{(const bf16_t*)(p.ws + WS_MG), WT + (size_t)2 * D * D, nullptr, nullptr, D, D, D / 64};
        pg8::StaticOrder S; S.init(M, D, G, bid);
        Epi3 E{p.x_prompt, p.x_sample, (const float*)(p.ws + WS_MOD), p.out};
        pg8::gemm_phase<Epi3, pg8::StaticOrder>(lds, g, S, E);
    }
    GRID_BAR();
    phase6(p, wave, lane);
}

extern "C" void kernel_launch(void* const* d_in, const int* in_sizes, int n_in, void* d_out, int out_size, void* d_ws, size_t ws_size, hipStream_t stream) {
    static int grid = 0;
    if (grid == 0) {
        if (n_in != 19 || ws_size < WS_END) { fprintf(stderr, "kernel_launch: expected 19 inputs and >= %zu bytes of workspace (got %d, %zu)\n", (size_t)WS_END, n_in, ws_size); grid = -1; return; }
        int dev = 0, cus = 0, per_cu = 0;
        hipGetDevice(&dev); hipDeviceGetAttribute(&cus, hipDeviceAttributeMultiprocessorCount, dev);
        if (hipFuncSetAttribute((const void*)mega_fwd, hipFuncAttributeMaxDynamicSharedMemorySize, LDS_BYTES) != hipSuccess) { fprintf(stderr, "kernel_launch: hipFuncSetAttribute failed\n"); grid = -1; return; }
        if (hipOccupancyMaxActiveBlocksPerMultiprocessor(&per_cu, (const void*)mega_fwd, 512, LDS_BYTES) != hipSuccess || per_cu < 1) { fprintf(stderr, "kernel_launch: occupancy query says %d blocks per CU\n", per_cu); per_cu = 1; }
        (void)hipGetLastError();
        grid = cus;
    }
    if (grid < 0) return;
    hipMemsetAsync(d_ws, 0, WS_ZERO_BYTES, stream);
    Params p{};
    const float** pp = (const float**)&p;
    for (int i = 0; i < 19; ++i) pp[i] = (const float*)d_in[i];
    p.out = (float*)d_out; p.ws = (unsigned char*)d_ws;
    hipLaunchKernelGGL(mega_fwd, dim3(grid), dim3(512), LDS_BYTES, stream, p);
    const hipError_t e = hipPeekAtLastError();
    if (e != hipSuccess) fprintf(stderr, "kernel_launch: launch failed: %s (grid %d)\n", hipGetErrorString(e), grid);
}
```
